# Optimizing an MI355X kernel written in HIP

```python
import jax, jax.numpy as jnp
from jax import lax
import numpy as np

D_MODEL = 1024
BATCH = 8
SEQ = 2048
DEPTH = 4
DEC_BATCH = 128
DEC_SEQ = 8
PAST_LEN = 8192
PAGE_SIZE = 128

N_HEADS = 8
HEAD_DIM = 64
N_KV_HEADS = 2
GROUP = N_HEADS // N_KV_HEADS
ATTN_DIM = N_HEADS * HEAD_DIM
KV_DIM = N_KV_HEADS * HEAD_DIM
WINDOW = 128
Q_BLOCK = 128
CONV_DIM = D_MODEL // 4
CONV_K = 31
POOL_DIM = D_MODEL // 4
POOL_WINDOWS = (2, 4, 8, 16)
N_POOL_GROUPS = 4
POOL_GROUP_DIM = POOL_DIM // N_POOL_GROUPS
POOL_MAX = 16
IN_DIM = ATTN_DIM + 2 * KV_DIM + 2 * CONV_DIM + POOL_DIM
MIX_DIM = ATTN_DIM + CONV_DIM + POOL_DIM
D_FF = ((8 * D_MODEL // 3 + 127) // 128) * 128
RMS_EPS = 1e-6
LN_EPS = 1e-5
NEG_INF = -1e30

kernel_name = "hymba_style_swa_conv_pool_macaron_decoder_step"


def rms_norm(x, g):
    xf = x.astype(jnp.float32)
    y = xf * lax.rsqrt(jnp.mean(xf * xf, axis=-1, keepdims=True) + RMS_EPS)
    return (y * g.astype(jnp.float32)).astype(x.dtype)


def layer_norm(x, g, b):
    xf = x.astype(jnp.float32)
    mu = jnp.mean(xf, axis=-1, keepdims=True)
    xc = xf - mu
    y = xc * lax.rsqrt(jnp.mean(xc * xc, axis=-1, keepdims=True) + LN_EPS)
    return (y * g.astype(jnp.float32) + b.astype(jnp.float32)).astype(x.dtype)


def swiglu(x, wg, wu, wd):
    return (jax.nn.silu(x @ wg) * (x @ wu)) @ wd


def alibi_slopes():
    return jnp.exp2(-8.0 * jnp.arange(1, N_HEADS + 1, dtype=jnp.float32) / N_HEADS)


def window_attention(q, k_ext, v_ext, sinks, pos0):
    B, T = q.shape[0], q.shape[1]
    bq = T if T <= Q_BLOCK else Q_BLOCK
    nb = T // bq
    span = WINDOW + bq
    kidx = jnp.arange(nb)[:, None] * bq + jnp.arange(span)[None, :]
    kb = k_ext[:, kidx]
    vb = v_ext[:, kidx]
    qb = q.reshape(B, nb, bq, N_KV_HEADS, GROUP, HEAD_DIM)
    scale = HEAD_DIM ** -0.5
    logits = jnp.einsum('bnqkgd,bnskd->bnkgqs', qb.astype(jnp.float32),
                        kb.astype(jnp.float32)) * scale
    t_pos = pos0 + jnp.arange(nb)[:, None] * bq + jnp.arange(bq)[None, :]
    s_pos = pos0 - WINDOW + kidx
    dist = t_pos[:, :, None] - s_pos[:, None, :]
    valid = (dist >= 0) & (dist < WINDOW) & (s_pos[:, None, :] >= 0)
    slopes = alibi_slopes().reshape(N_KV_HEADS, GROUP)
    bias = -slopes[None, :, :, None, None] * dist[:, None, None, :, :].astype(jnp.float32)
    logits = jnp.where(valid[:, None, None], logits + bias, NEG_INF)
    sink = sinks.astype(jnp.float32).reshape(N_KV_HEADS, GROUP)[None, None, :, :, None, None]
    m = jnp.maximum(jnp.max(logits, axis=-1, keepdims=True), sink)
    e = jnp.exp(logits - m)
    p = e / (jnp.sum(e, axis=-1, keepdims=True) + jnp.exp(sink - m))
    out = jnp.einsum('bnkgqs,bnskd->bnqkgd', p.astype(v_ext.dtype), vb)
    return out.reshape(B, T, ATTN_DIM)


def conv_module(g_ext, dw_w, dw_b, ln_g, ln_b, pw_w):
    c = lax.conv_general_dilated(g_ext, dw_w[:, None, :].astype(g_ext.dtype), (1,), 'VALID',
                                 dimension_numbers=('NWC', 'WIO', 'NWC'),
                                 feature_group_count=CONV_DIM) + dw_b
    c = layer_norm(c, ln_g, ln_b)
    return jax.nn.silu(c) @ pw_w


def pool_mixer(p_ext, pos0, pool_w, pool_scale):
    P = POOL_MAX - 1
    B, T = p_ext.shape[0], p_ext.shape[1] - P
    pf = p_ext.astype(jnp.float32)
    csum = jnp.cumsum(jnp.pad(pf, ((0, 0), (1, 0), (0, 0))), axis=1)
    cur = pf[:, P:]
    pos = pos0 + jnp.arange(T)
    diffs = []
    for g, w in enumerate(POOL_WINDOWS):
        sl = slice(g * POOL_GROUP_DIM, (g + 1) * POOL_GROUP_DIM)
        wsum = csum[:, P + 1:P + 1 + T, sl] - csum[:, P + 1 - w:P + 1 - w + T, sl]
        cnt = jnp.minimum(w, pos + 1).astype(jnp.float32)[None, :, None]
        diffs.append(wsum / cnt - cur[:, :, sl])
    d = jnp.stack(diffs, axis=2)
    out = jnp.einsum('btgc,gcd->btgd', d, pool_w.astype(jnp.float32)).reshape(B, T, POOL_DIM)
    return (out * pool_scale.astype(jnp.float32)).astype(p_ext.dtype)


def trunk_layer(x, k_buf, v_buf, conv_buf, pool_buf, pos0,
                norm_g, f1g, f1u, f1d, w_in, sinks, dw_w, dw_b, ln_g, ln_b, pw_w,
                pool_w, pool_scale, w_out, f2g, f2u, f2d):
    B, T = x.shape[0], x.shape[1]
    h = x + 0.5 * rms_norm(swiglu(rms_norm(x, norm_g[0]), f1g, f1u, f1d), norm_g[1])
    u = rms_norm(h, norm_g[2])
    z = u @ w_in
    o = 0
    q = z[..., o:o + ATTN_DIM].reshape(B, T, N_HEADS, HEAD_DIM); o += ATTN_DIM
    k = z[..., o:o + KV_DIM].reshape(B, T, N_KV_HEADS, HEAD_DIM); o += KV_DIM
    v = z[..., o:o + KV_DIM].reshape(B, T, N_KV_HEADS, HEAD_DIM); o += KV_DIM
    ga = z[..., o:o + CONV_DIM]; o += CONV_DIM
    gb = z[..., o:o + CONV_DIM]; o += CONV_DIM
    pu = z[..., o:o + POOL_DIM]
    k_ext = jnp.concatenate([k_buf, k], axis=1)
    v_ext = jnp.concatenate([v_buf, v], axis=1)
    attn = window_attention(q, k_ext, v_ext, sinks, pos0)
    g_ext = jnp.concatenate([conv_buf, ga * jax.nn.sigmoid(gb)], axis=1)
    conv = conv_module(g_ext, dw_w, dw_b, ln_g, ln_b, pw_w)
    p_ext = jnp.concatenate([pool_buf, pu], axis=1)
    pool = pool_mixer(p_ext, pos0, pool_w, pool_scale)
    mix = jnp.concatenate([attn, conv, pool], axis=-1) @ w_out
    h = h + rms_norm(mix, norm_g[3])
    y = h + 0.5 * rms_norm(swiglu(rms_norm(h, norm_g[4]), f2g, f2u, f2d), norm_g[5])
    return (y, k_ext[:, -WINDOW:], v_ext[:, -WINDOW:],
            g_ext[:, -(CONV_K - 1):], p_ext[:, -(POOL_MAX - 1):])


def setup_inputs(seed: int = 0) -> dict:
    key = jax.random.key(seed)
    ks = jax.random.split(key, 24)
    nrm = lambda k, s, sc: jax.random.normal(k, s, jnp.float32) * sc
    return {
        "x_prompt": nrm(ks[0], (BATCH, SEQ, D_MODEL), 1.0),
        "x_sample": nrm(ks[1], (DEC_BATCH, DEC_SEQ, D_MODEL), 1.0),
        "state_attn_k": nrm(ks[2], (DEPTH, DEC_BATCH, WINDOW, N_KV_HEADS, HEAD_DIM), 1.0),
        "state_attn_v": nrm(ks[3], (DEPTH, DEC_BATCH, WINDOW, N_KV_HEADS, HEAD_DIM), 1.0),
        "state_conv": nrm(ks[4], (DEPTH, DEC_BATCH, CONV_K - 1, CONV_DIM), 0.5),
        "state_pool": nrm(ks[5], (DEPTH, DEC_BATCH, POOL_MAX - 1, POOL_DIM), 1.0),
        "norm_g": 1.0 + nrm(ks[6], (DEPTH, 6, D_MODEL), 0.02),
        "ffn1_wg": nrm(ks[7], (DEPTH, D_MODEL, D_FF), D_MODEL ** -0.5),
        "ffn1_wu": nrm(ks[8], (DEPTH, D_MODEL, D_FF), D_MODEL ** -0.5),
        "ffn1_wd": nrm(ks[9], (DEPTH, D_FF, D_MODEL), D_FF ** -0.5),
        "w_in": nrm(ks[10], (DEPTH, D_MODEL, IN_DIM), D_MODEL ** -0.5),
        "attn_sinks": nrm(ks[11], (DEPTH, N_HEADS), 0.5),
        "conv_dw_w": nrm(ks[12], (DEPTH, CONV_K, CONV_DIM), CONV_K ** -0.5),
        "conv_dw_b": nrm(ks[13], (DEPTH, CONV_DIM), 0.02),
        "conv_ln_g": 1.0 + nrm(ks[14], (DEPTH, CONV_DIM), 0.02),
        "conv_ln_b": nrm(ks[15], (DEPTH, CONV_DIM), 0.02),
        "conv_pw_w": nrm(ks[16], (DEPTH, CONV_DIM, CONV_DIM), CONV_DIM ** -0.5),
        "pool_w": nrm(ks[17], (DEPTH, N_POOL_GROUPS, POOL_GROUP_DIM, POOL_GROUP_DIM), POOL_GROUP_DIM ** -0.5),
        "pool_scale": 1.0 + nrm(ks[18], (DEPTH, POOL_DIM), 0.1),
        "w_out": nrm(ks[19], (DEPTH, MIX_DIM, D_MODEL), MIX_DIM ** -0.5),
        "ffn2_wg": nrm(ks[20], (DEPTH, D_MODEL, D_FF), D_MODEL ** -0.5),
        "ffn2_wu": nrm(ks[21], (DEPTH, D_MODEL, D_FF), D_MODEL ** -0.5),
        "ffn2_wd": nrm(ks[22], (DEPTH, D_FF, D_MODEL), D_FF ** -0.5),
    }


def reference(x_prompt, x_sample, state_attn_k, state_attn_v, state_conv, state_pool,
              norm_g, ffn1_wg, ffn1_wu, ffn1_wd, w_in, attn_sinks, conv_dw_w, conv_dw_b,
              conv_ln_g, conv_ln_b, conv_pw_w, pool_w, pool_scale, w_out,
              ffn2_wg, ffn2_wu, ffn2_wd):
    params = (norm_g, ffn1_wg, ffn1_wu, ffn1_wd, w_in, attn_sinks, conv_dw_w, conv_dw_b,
              conv_ln_g, conv_ln_b, conv_pw_w, pool_w, pool_scale, w_out,
              ffn2_wg, ffn2_wu, ffn2_wd)
    dt = x_prompt.dtype
    zk = jnp.zeros((BATCH, WINDOW, N_KV_HEADS, HEAD_DIM), dt)
    zc = jnp.zeros((BATCH, CONV_K - 1, CONV_DIM), dt)
    zp = jnp.zeros((BATCH, POOL_MAX - 1, POOL_DIM), dt)
    hp, hs = x_prompt, x_sample
    kp, vp, cp, pp, ksl, vsl, csl, psl = [], [], [], [], [], [], [], []
    for l in range(DEPTH):
        lp = [p[l] for p in params]
        hp, k1, v1, c1, p1 = trunk_layer(hp, zk, zk, zc, zp, 0, *lp)
        hs, k2, v2, c2, p2 = trunk_layer(hs, state_attn_k[l], state_attn_v[l],
                                         state_conv[l], state_pool[l], PAST_LEN, *lp)
        kp.append(k1); vp.append(v1); cp.append(c1); pp.append(p1)
        ksl.append(k2); vsl.append(v2); csl.append(c2); psl.append(p2)
    return (hp, hs,
            jnp.stack(kp), jnp.stack(vp), jnp.stack(cp), jnp.stack(pp),
            jnp.stack(ksl), jnp.stack(vsl), jnp.stack(csl), jnp.stack(psl))
```

```cpp
#include <hip/hip_runtime.h>
#include <hip/hip_cooperative_groups.h>
#include <cstdio>
#include <cstdint>
namespace cg = cooperative_groups;
#ifndef MK_MULTI_LAUNCH
#define MK_MULTI_LAUNCH 0
#endif
namespace pg8 {
#define PG8_LAS __attribute__((address_space(3)))
typedef unsigned short bf16_t;
typedef short bf16x8 __attribute__((ext_vector_type(8)));
typedef float f32x4 __attribute__((ext_vector_type(4)));
typedef unsigned u32x4 __attribute__((ext_vector_type(4)));
constexpr int BM = 256, BK = 64, HALF = 128, HTB = HALF * BK * 2  , STAGE_BYTES = 8 * HTB, NXCD = 8, WGM = 8;

__host__ __device__ __forceinline__ int lds_byte(int r, int c) { const int st = (r >> 4) * 2 + (c >> 5), rr = r & 15, cc = c & 31, ob = rr * 64 + cc * 2; return st * 1024 + (ob ^ (((ob >> 9) & 1) << 5)); }
__host__ __device__ __forceinline__ void stage_rc(int b, int& R, int& C) { const int st = b / 1024, sb = b % 1024, swz = sb ^ (((sb >> 9) & 1) << 5); R = (st >> 1) * 16 + swz / 64; C = (st & 1) * 32 + (swz % 64) / 2; }
__host__ __device__ __forceinline__ int perm32(int rho) { const int n = rho >> 4, i = rho & 15; return 8 * (i >> 2) + 4 * n + (i & 3); }

struct Unit { int pm, pn, k0, nk, which; };
struct Gemm { const bf16_t* A; const bf16_t* Bt; int M, N, K; };

struct StaticOrder {
    static constexpr bool SPLITK = false;
    int nM, nN, nwg, G, c;
    __host__ __device__ void init(int M, int N, int G_, int c_) { nM = M / BM; nN = N / BM; nwg = nM * nN; G = G_; c = c_; }
    __host__ __device__ bool next(int i, Unit& u) const {
        const long L = (long)i * G + c; if (L >= nwg) return false;
        int wgid = (int)L; { const int q = nwg / NXCD, r = nwg % NXCD, xcd = wgid % NXCD, off = wgid / NXCD; wgid = (xcd < r ? xcd * (q + 1) : r * (q + 1) + (xcd - r) * q) + off; }
        const int nig = WGM * nN, gid = wgid / nig, fm = gid * WGM, gsz = (nM - fm) < WGM ? (nM - fm) : WGM;
        u.pm = fm + ((wgid % nig) % gsz); u.pn = (wgid % nig) / gsz; return true;
    }
    __device__ __forceinline__ void a_ready(const Unit&) const {}
    __device__ __forceinline__ void done(const Unit&) const {}
};

struct StreamKOrder {
    static constexpr bool SPLITK = true;
    int nN, ppu, G, lo, hi, T;
    __host__ __device__ void init(int M, int N, int K, int G_, int vc) { nN = N / BM; ppu = K / (2 * BK); G = G_; T = (M / BM) * nN * ppu; lo = vc * T / G; hi = (vc + 1) * T / G; }
    __host__ __device__ bool next(int i, Unit& u) const {
        const int un = lo / ppu + i; const int s = un * ppu > lo ? un * ppu : lo, e = (un + 1) * ppu < hi ? (un + 1) * ppu : hi;
        if (s >= e) return false;
        u.pm = un / nN; u.pn = un % nN; u.k0 = 2 * (s - un * ppu); u.nk = 2 * (e - s); u.which = (s > un * ppu) ? 1 : 0; return true;
    }
    __device__ __forceinline__ void a_ready(const Unit&) const {}
    __device__ __forceinline__ void done(const Unit&) const {}
};

struct HybridOrder {
    static constexpr bool SPLITK = true;
    StaticOrder so; int c, ppu, nsl;
    __host__ __device__ void init(int K, int G_, int c_) { so.init(64 * BM, 1024, G_, c_); c = c_; ppu = K / (2 * BK); nsl = ppu < 16 ? ppu : 16; }
    __host__ __device__ bool next(int i, Unit& u) const {
        if (i == 0) { const bool ok = so.next(0, u); u.k0 = 0; u.nk = 2 * ppu; u.which = -1; return ok; }
        if (i == 1) { const int lu = c >> 4, s = c & 15; if (s >= nsl || lu >= 16) return false; const int q = ppu / nsl, r = ppu % nsl; const int start = s < r ? s * (q + 1) : r * (q + 1) + (s - r) * q, len = s < r ? q + 1 : q;
            u.pm = 64 + (lu >> 2); u.pn = lu & 3; u.k0 = 2 * start; u.nk = 2 * len; u.which = s; return true; }
        return false;
    }
    __device__ __forceinline__ void a_ready(const Unit&) const {}
    __device__ __forceinline__ void done(const Unit&) const {}
};

typedef float f32x2_t __attribute__((ext_vector_type(2))); typedef __bf16 bf16x2_t __attribute__((ext_vector_type(2)));
__device__ __forceinline__ unsigned cvt_pk_bf16(float lo, float hi) { unsigned r; asm volatile("v_cvt_pk_bf16_f32 %0, %1, %2" : "=v"(r) : "v"(lo), "v"(hi)); return r; }
__device__ __forceinline__ unsigned cvt_pk_s(float lo, float hi) { f32x2_t v = {lo, hi}; bf16x2_t b = __builtin_convertvector(v, bf16x2_t); return __builtin_bit_cast(unsigned, b); }
typedef unsigned u32x2 __attribute__((ext_vector_type(2)));
__device__ __forceinline__ float sigmoidf_fast(float x) { return __builtin_amdgcn_rcpf(1.0f + __builtin_amdgcn_exp2f(-1.44269504f * x)); }
struct EpiPlain {
    static constexpr bool PERM = true, AFTER_DRAIN = false;
    bf16_t* O; int ldc; float one; size_t off1;
    __device__ __forceinline__ void operator()(const f32x4 (&acc)[2][2][4][2], const Unit& u, int wr, int wc, int fr, int fq) const {
        const int row0 = u.pm * BM + wr * 64 + fr; const int col0 = u.pn * BM + wc * 32 + 8 * fq;
#pragma unroll
        for (int ai = 0; ai < 2; ++ai)
#pragma unroll
            for (int m = 0; m < 4; ++m) { bf16_t* rowp = (u.which < 0 ? O : O + off1 + (size_t)u.which * (1024 * 1024) - (size_t)(64 * BM) * 1024) + (size_t)(row0 + ai * HALF + m * 16) * ldc + col0;
#pragma unroll
                for (int bj = 0; bj < 2; ++bj) { const f32x4 v0 = acc[ai][bj][m][0] * one, v1 = acc[ai][bj][m][1] * one;
                    u32x4 w; w.x = cvt_pk_bf16(v0[0], v0[1]); w.y = cvt_pk_bf16(v0[2], v0[3]); w.z = cvt_pk_bf16(v1[0], v1[1]); w.w = cvt_pk_bf16(v1[2], v1[3]);
                    *(u32x4*)(rowp + bj * HALF) = w; } }
    }
};
struct EpiSwiGLU {
    static constexpr bool PERM = true, AFTER_DRAIN = false;
    bf16_t* O; int ldc;
    __device__ __forceinline__ void operator()(const f32x4 (&acc)[2][2][4][2], const Unit& u, int wr, int wc, int fr, int fq) const {
        const int row0 = u.pm * BM + wr * 64 + fr; const int col0 = u.pn * HALF + wc * 32 + 8 * fq;
#pragma unroll
        for (int ai = 0; ai < 2; ++ai)
#pragma unroll
            for (int m = 0; m < 4; ++m) { bf16_t* rowp = O + (size_t)(row0 + ai * HALF + m * 16) * ldc + col0;
                float r[8];
#pragma unroll
                for (int n = 0; n < 2; ++n)
#pragma unroll
                    for (int e = 0; e < 4; ++e) { const float g = acc[ai][0][m][n][e], up = acc[ai][1][m][n][e]; r[n * 4 + e] = g * sigmoidf_fast(g) * up; }
                u32x4 w; w.x = cvt_pk_bf16(r[0], r[1]); w.y = cvt_pk_bf16(r[2], r[3]); w.z = cvt_pk_bf16(r[4], r[5]); w.w = cvt_pk_bf16(r[6], r[7]);
                *(u32x4*)rowp = w; }
    }
};
struct EpiZ {
    static constexpr bool PERM = true, AFTER_DRAIN = false;
    bf16_t* O; int ldc; float one;
    __device__ __forceinline__ void operator()(const f32x4 (&acc)[2][2][4][2], const Unit& u, int wr, int wc, int fr, int fq) const {
        const int row0 = u.pm * BM + wr * 64 + fr;
        if (u.pn == 3 || u.pn == 4) {
            const int col0 = 768 + (u.pn - 3) * HALF + wc * 32 + 8 * fq;
#pragma unroll
            for (int ai = 0; ai < 2; ++ai)
#pragma unroll
                for (int m = 0; m < 4; ++m) { bf16_t* rowp = O + (size_t)(row0 + ai * HALF + m * 16) * ldc + col0;
                    float r[8];
#pragma unroll
                    for (int n = 0; n < 2; ++n)
#pragma unroll
                        for (int e = 0; e < 4; ++e) { const float ga = acc[ai][0][m][n][e], gb = acc[ai][1][m][n][e]; r[n * 4 + e] = ga * sigmoidf_fast(gb); }
                    u32x4 w; w.x = cvt_pk_bf16(r[0], r[1]); w.y = cvt_pk_bf16(r[2], r[3]); w.z = cvt_pk_bf16(r[4], r[5]); w.w = cvt_pk_bf16(r[6], r[7]);
                    *(u32x4*)rowp = w; }
        } else {
            const int col0 = (u.pn == 5 ? 1024 : u.pn * BM) + wc * 32 + 8 * fq;
#pragma unroll
            for (int ai = 0; ai < 2; ++ai)
#pragma unroll
                for (int m = 0; m < 4; ++m) { bf16_t* rowp = O + (size_t)(row0 + ai * HALF + m * 16) * ldc + col0;
#pragma unroll
                    for (int bj = 0; bj < 2; ++bj) { const f32x4 v0 = acc[ai][bj][m][0] * one, v1 = acc[ai][bj][m][1] * one;
                        u32x4 w; w.x = cvt_pk_bf16(v0[0], v0[1]); w.y = cvt_pk_bf16(v0[2], v0[3]); w.z = cvt_pk_bf16(v1[0], v1[1]); w.w = cvt_pk_bf16(v1[2], v1[3]);
                        *(u32x4*)(rowp + bj * HALF) = w; } }
        }
    }
};

template <class Epi, class Sched, bool ALIGN_EPI = false, bool SP2 = false>
__device__ __forceinline__ void gemm_phase(PG8_LAS unsigned char* lds, const Gemm g, const Sched& S, const Epi& E) {
    int tid_ = threadIdx.x; asm volatile("" : "+v"(tid_)); const int tid = tid_, wid = __builtin_amdgcn_readfirstlane(tid >> 6), lane = tid & 63, wr = wid >> 2, wc = wid & 3, fr = lane & 15, fq = lane >> 4;
    const int K = g.K, nt_full = K / BK;
    unsigned voffA[2], voffB[2];
#pragma unroll
    for (int i = 0; i < 2; ++i) { int R, C; stage_rc(tid * 16 + i * 8192, R, C); const int Rb = Epi::PERM ? ((R & ~31) + perm32(R & 31)) : R;
        voffA[i] = (unsigned)(R * K + C) * 2u; voffB[i] = (unsigned)(Rb * K + C) * 2u; }
    const size_t kstep = (size_t)(BK * 2);
    const size_t hstep = (size_t)HALF * K * 2;
    const size_t tstep = 2 * hstep;
    const unsigned ldsw = (unsigned)wid * 1024u;
    const int aoff = lds_byte(wr * 64 + fr, fq * 8), boff = lds_byte(wc * 32 + fr, fq * 8);
#define PG8_SA(b, h) (((b) * 2 + (h)) * HTB)
#define PG8_SB(b, h) ((4 + (b) * 2 + (h)) * HTB)
#define PG8_STAGE(bufoff, gbase, voff) do { _Pragma("unroll") for (int _i = 0; _i < 2; ++_i) \
        __builtin_amdgcn_global_load_lds((const unsigned*)((const char*)(gbase) + (voff)[_i]), (PG8_LAS unsigned*)(lds + (bufoff) + ldsw + _i * 8192), 16, 0, 0); } while (0)
#define PG8_LDA(dst, b, h) do { _Pragma("unroll") for (int m = 0; m < 4; ++m) _Pragma("unroll") for (int k = 0; k < 2; ++k) dst[m][k] = *(const PG8_LAS bf16x8*)(lds + PG8_SA(b, h) + aoff + m * 2048 + k * 1024); } while (0)
#define PG8_LDB(dst, b, h) do { _Pragma("unroll") for (int n = 0; n < 2; ++n) _Pragma("unroll") for (int k = 0; k < 2; ++k) dst[n][k] = *(const PG8_LAS bf16x8*)(lds + PG8_SB(b, h) + boff + n * 2048 + k * 1024); } while (0)
#define PG8_MMA(ai, bj, At, Bt) do { __builtin_amdgcn_s_setprio(1); _Pragma("unroll") for (int m = 0; m < 4; ++m) _Pragma("unroll") for (int n = 0; n < 2; ++n) _Pragma("unroll") for (int k = 0; k < 2; ++k) \
        acc[ai][bj][m][n] = __builtin_amdgcn_mfma_f32_16x16x32_bf16(Bt[n][k], At[m][k], acc[ai][bj][m][n], 0, 0, 0); __builtin_amdgcn_s_setprio(0); } while (0)
#define PG8_WAIT_V(n) asm volatile("s_waitcnt vmcnt(" #n ")" ::: "memory")
#define PG8_WAIT_L(n) asm volatile("s_waitcnt lgkmcnt(" #n ")" ::: "memory")
#define PG8_BAR __builtin_amdgcn_s_barrier()
#define PG8_SCHED __builtin_amdgcn_sched_barrier(0)
    Unit cur, nxt; int ui = 0;
    if (!S.next(0, cur)) return;
    f32x4 acc[2][2][4][2];
#pragma unroll
    for (int a = 0; a < 2; ++a)
#pragma unroll
        for (int b = 0; b < 2; ++b)
#pragma unroll
            for (int m = 0; m < 4; ++m)
#pragma unroll
                for (int n = 0; n < 2; ++n) acc[a][b][m][n] = (f32x4){0.f, 0.f, 0.f, 0.f};
    bf16x8 At[4][2], B0[2][2], B1[2][2];
    if (!Sched::SPLITK) { cur.k0 = 0; cur.nk = nt_full; cur.which = 0; }
    const char* cA = (const char*)g.A + (size_t)cur.pm * tstep + (size_t)cur.k0 * (BK * 2); const char* cB = (const char*)g.Bt + (size_t)cur.pn * tstep + (size_t)cur.k0 * (BK * 2);
    S.a_ready(cur);
    if constexpr (SP2) {
        PG8_STAGE(PG8_SB(0, 0), cB, voffB); PG8_STAGE(PG8_SB(0, 1), cB + hstep, voffB); PG8_STAGE(PG8_SA(0, 0), cA, voffA); PG8_STAGE(PG8_SA(0, 1), cA + hstep, voffA);
        if (wr == 1) PG8_BAR;
        PG8_WAIT_V(2); PG8_BAR;
        PG8_STAGE(PG8_SB(1, 0), cB + kstep, voffB); PG8_STAGE(PG8_SA(1, 0), cA + kstep, voffA); PG8_STAGE(PG8_SB(1, 1), cB + hstep + kstep, voffB);
        PG8_WAIT_V(6); PG8_BAR;
    } else {
        PG8_STAGE(PG8_SB(0, 0), cB, voffB); PG8_STAGE(PG8_SA(0, 0), cA, voffA); PG8_STAGE(PG8_SB(0, 1), cB + hstep, voffB); PG8_STAGE(PG8_SA(0, 1), cA + hstep, voffA);
        if (wr == 1) PG8_BAR;
        PG8_WAIT_V(4); PG8_BAR;
        PG8_STAGE(PG8_SB(1, 0), cB + kstep, voffB); PG8_STAGE(PG8_SA(1, 0), cA + kstep, voffA); PG8_STAGE(PG8_SB(1, 1), cB + hstep + kstep, voffB);
        PG8_WAIT_V(6); PG8_BAR;
    }
    for (;;) {
        const bool has_next = S.next(ui + 1, nxt);
        if (!Sched::SPLITK) { nxt.k0 = 0; nxt.nk = nt_full; nxt.which = 0; }
        const char* nA = has_next ? (const char*)g.A + (size_t)nxt.pm * tstep + (size_t)nxt.k0 * (BK * 2) : cA; const char* nB = has_next ? (const char*)g.Bt + (size_t)nxt.pn * tstep + (size_t)nxt.k0 * (BK * 2) : cB;
        const int nt = cur.nk;
        for (int t = 0; t < nt; t += 2) {
            const bool last = (t == nt - 2);
            const char* a1 = cA + (size_t)(t + 1) * kstep;
            const char* a2 = last ? nA : cA + (size_t)(t + 2) * kstep; const char* b2 = last ? nB : cB + (size_t)(t + 2) * kstep;
            const char* a3 = a2 + kstep; const char* b3 = b2 + kstep;
            if (last && has_next) S.a_ready(nxt);
            if constexpr (SP2) {
            PG8_LDB(B0, 0, 0); PG8_LDB(B1, 0, 1); PG8_SCHED; PG8_LDA(At, 0, 0); PG8_STAGE(PG8_SA(1, 1), a1 + hstep, voffA);
            PG8_WAIT_V(8); PG8_WAIT_L(0); PG8_BAR; PG8_MMA(0, 0, At, B0); PG8_MMA(0, 1, At, B1); PG8_BAR; PG8_SCHED;
            PG8_LDA(At, 0, 1); PG8_STAGE(PG8_SB(0, 0), b2, voffB); PG8_STAGE(PG8_SB(0, 1), b2 + hstep, voffB); PG8_STAGE(PG8_SA(0, 0), a2, voffA);
            PG8_WAIT_V(8); PG8_WAIT_L(0); PG8_BAR; PG8_MMA(1, 0, At, B0); PG8_MMA(1, 1, At, B1); PG8_BAR; PG8_SCHED;
            PG8_LDB(B0, 1, 0); PG8_LDB(B1, 1, 1); PG8_SCHED; PG8_LDA(At, 1, 0); PG8_STAGE(PG8_SA(0, 1), a2 + hstep, voffA);
            PG8_WAIT_V(8); PG8_WAIT_L(0); PG8_BAR; PG8_MMA(0, 0, At, B0); PG8_MMA(0, 1, At, B1); PG8_BAR; PG8_SCHED;
            PG8_LDA(At, 1, 1); PG8_STAGE(PG8_SB(1, 0), b3, voffB); PG8_STAGE(PG8_SB(1, 1), b3 + hstep, voffB); PG8_STAGE(PG8_SA(1, 0), a3, voffA);
            PG8_WAIT_V(8); PG8_WAIT_L(0); PG8_BAR; PG8_MMA(1, 0, At, B0); PG8_MMA(1, 1, At, B1); PG8_BAR; PG8_SCHED;
            } else {
            PG8_LDB(B0, 0, 0); PG8_SCHED; PG8_LDA(At, 0, 0); PG8_STAGE(PG8_SA(1, 1), a1 + hstep, voffA);
            PG8_WAIT_L(8); PG8_BAR; PG8_WAIT_L(0); PG8_MMA(0, 0, At, B0); PG8_BAR; PG8_SCHED;
            PG8_LDB(B1, 0, 1); PG8_STAGE(PG8_SB(0, 0), b2, voffB);
            PG8_BAR; PG8_WAIT_L(0); PG8_MMA(0, 1, At, B1); PG8_BAR;
            PG8_LDA(At, 0, 1); PG8_STAGE(PG8_SA(0, 0), a2, voffA);
            PG8_BAR; PG8_WAIT_L(0); PG8_MMA(1, 0, At, B0); PG8_BAR; PG8_SCHED;
            PG8_STAGE(PG8_SB(0, 1), b2 + hstep, voffB);
            PG8_WAIT_V(6); PG8_BAR; PG8_MMA(1, 1, At, B1); PG8_BAR;
            PG8_LDB(B0, 1, 0); PG8_SCHED; PG8_LDA(At, 1, 0); PG8_STAGE(PG8_SA(0, 1), a2 + hstep, voffA);
            PG8_WAIT_L(8); PG8_BAR; PG8_WAIT_L(0); PG8_MMA(0, 0, At, B0); PG8_BAR; PG8_SCHED;
            PG8_LDB(B1, 1, 1); PG8_STAGE(PG8_SB(1, 0), b3, voffB);
            PG8_BAR; PG8_WAIT_L(0); PG8_MMA(0, 1, At, B1); PG8_BAR;
            PG8_LDA(At, 1, 1); PG8_STAGE(PG8_SA(1, 0), a3, voffA);
            PG8_BAR; PG8_WAIT_L(0); PG8_MMA(1, 0, At, B0); PG8_BAR; PG8_SCHED;
            PG8_STAGE(PG8_SB(1, 1), b3 + hstep, voffB);
            PG8_WAIT_V(6); PG8_BAR; PG8_MMA(1, 1, At, B1); PG8_BAR;
            }
        }
        if constexpr (ALIGN_EPI) { if (wr == 0) PG8_BAR; }
        if constexpr (!Epi::AFTER_DRAIN) { E(acc, cur, wr, wc, fr, fq); S.done(cur); }
        if (!has_next) break;
#pragma unroll
        for (int a = 0; a < 2; ++a)
#pragma unroll
            for (int b = 0; b < 2; ++b)
#pragma unroll
                for (int m = 0; m < 4; ++m)
#pragma unroll
                    for (int n = 0; n < 2; ++n) acc[a][b][m][n] = (f32x4){0.f, 0.f, 0.f, 0.f};
        cur = nxt; cA = nA; cB = nB; ++ui;
        if constexpr (ALIGN_EPI) { if (wr == 1) PG8_BAR; }
    }
    PG8_WAIT_V(0);
    if constexpr (!ALIGN_EPI) { if (wr == 0) PG8_BAR; }
    PG8_BAR;
    if constexpr (Epi::AFTER_DRAIN) { E.fused(acc, cur, wr, wc, fr, fq, lds, wid, lane); S.done(cur); }
#undef PG8_SA
#undef PG8_SB
#undef PG8_STAGE
#undef PG8_LDA
#undef PG8_LDB
#undef PG8_MMA
#undef PG8_WAIT_V
#undef PG8_WAIT_L
#undef PG8_BAR
#undef PG8_SCHED
}
}
constexpr int DM = 1024, MP = 16384, MS = 1024, MTOK = MP + MS, DFF = 2816, NGU = 2 * DFF, NIN = 1536, ZLD = 1280, DEPTH = 4;
constexpr int SEQ = 2048, DSEQ = 8, NB = 8, NDB = 128;
constexpr float RMS_EPS = 1e-6f, LN_EPS = 1e-5f;
constexpr size_t O_Y = 0, O_KP = 17825792, O_VP = 18350080, O_CP = 18874368, O_PP = 19120128, O_KS = 19243008, O_VS = 27631616, O_CS = 36020224, O_PS = 39952384, O_END = 41918464;
constexpr size_t MiB = 1u << 20;
constexpr size_t WS_WPAD = 128 * 1024;
constexpr size_t WS_W = 1 * MiB, W_LAYER = 38 * MiB;
constexpr size_t W_GU1 = 0, W_D1 = 11 * MiB, W_IN = 16 * MiB + MiB / 2, W_OUT = 19 * MiB + MiB / 2, W_GU2 = 21 * MiB + MiB / 2, W_D2 = 32 * MiB + MiB / 2;
constexpr size_t WS_U = WS_W + 4 * W_LAYER;
constexpr size_t WS_ACT = WS_U + 34 * MiB;
constexpr size_t WS_Z = WS_ACT, WS_MIX = WS_ACT + 48 * MiB;
constexpr size_t WS_D1 = WS_ACT + 94 * MiB;
constexpr size_t WS_HB = WS_D1 + 34 * MiB;
constexpr size_t WS_END = WS_HB + 34 * MiB;
static_assert((size_t)MTOK * DM * 2 <= 34 * MiB && (size_t)MTOK * DFF * 2 <= 94 * MiB && (size_t)MTOK * ZLD * 2 <= 48 * MiB && 48 * MiB + (size_t)MTOK * DM * 2 <= 94 * MiB, "ws map");
constexpr int LDS_BYTES = 147456;
#ifndef MK_DUP
#define MK_DUP 0
#endif
#define REP(bit) for (int rep_ = 0; rep_ < ((MK_DUP & (bit)) ? 2 : 1); ++rep_)
constexpr int NPH_FULL = 1 + 10 * DEPTH;
#ifndef MK_PH_HI
#define MK_PH_HI NPH_FULL
#endif
constexpr int NPH = MK_PH_HI;

#define LAS __attribute__((address_space(3)))
typedef unsigned short bf16;
typedef float f32x4 __attribute__((ext_vector_type(4)));
typedef short bf16x8 __attribute__((ext_vector_type(8)));
typedef unsigned u32x4 __attribute__((ext_vector_type(4)));
typedef unsigned u32x2 __attribute__((ext_vector_type(2)));
#define LDS_WAIT() asm volatile("s_waitcnt lgkmcnt(0)" ::: "memory")
using pg8::cvt_pk_bf16;
__device__ __forceinline__ void st_bf4_mfma(unsigned short* p, float __attribute__((ext_vector_type(4))) v) { unsigned __attribute__((ext_vector_type(2))) w; w.x = pg8::cvt_pk_s(v.x, v.y); w.y = pg8::cvt_pk_s(v.z, v.w); *(unsigned __attribute__((ext_vector_type(2)))*)p = w; }
__device__ __forceinline__ float bf2f(unsigned short b) { return __uint_as_float((unsigned)b << 16); }
__device__ __forceinline__ f32x4 ld_bf4(const bf16* p) { const u32x2 v = *(const u32x2*)p; f32x4 r; r.x = __uint_as_float(v.x << 16); r.y = __uint_as_float(v.x & 0xffff0000u); r.z = __uint_as_float(v.y << 16); r.w = __uint_as_float(v.y & 0xffff0000u); return r; }
__device__ __forceinline__ void st_bf4(bf16* p, f32x4 v) { u32x2 w; w.x = cvt_pk_bf16(v.x, v.y); w.y = cvt_pk_bf16(v.z, v.w); *(u32x2*)p = w; }
__device__ __forceinline__ float dpp_xadd(float v, int ctrl) { return v; }
template <int CTRL> __device__ __forceinline__ float dpp_add(float v) { return v + __builtin_bit_cast(float, __builtin_amdgcn_update_dpp(0, __builtin_bit_cast(int, v), CTRL, 0xf, 0xf, false)); }
__device__ __forceinline__ float wave_sum(float v) {
    v = dpp_add<0xB1>(v); v = dpp_add<0x4E>(v); v = dpp_add<0x141>(v); v = dpp_add<0x140>(v);
    const int b = __builtin_bit_cast(int, v);
    return (__builtin_bit_cast(float, __builtin_amdgcn_readlane(b, 0)) + __builtin_bit_cast(float, __builtin_amdgcn_readlane(b, 16))) + (__builtin_bit_cast(float, __builtin_amdgcn_readlane(b, 32)) + __builtin_bit_cast(float, __builtin_amdgcn_readlane(b, 48)));
}

struct Params { const float* in[23]; float* out; unsigned char* ws; int ph_lo, ph_hi; float one; int pad; };
enum { I_XP = 0, I_XS, I_SK, I_SV, I_SC, I_SP, I_NG, I_F1G, I_F1U, I_F1D, I_WIN, I_SINK, I_DWW, I_DWB, I_LNG, I_LNB, I_PW, I_POOLW, I_PSC, I_WOUT, I_F2G, I_F2U, I_F2D };

__device__ __forceinline__ void transpose_item(const float* __restrict__ W, int N, int k0, int n0, bf16* dst, int ldk, LAS float* scr, int lane) {
    float v[32];
#pragma unroll
    for (int i = 0; i < 32; ++i) { const int kk = 2 * i + (lane >> 5); v[i] = __builtin_nontemporal_load(W + (size_t)(k0 + kk) * N + n0 + (lane & 31)); }
#pragma unroll
    for (int i = 0; i < 32; ++i) { const int kk = 2 * i + (lane >> 5); scr[kk * 33 + (lane & 31)] = v[i]; }
    LDS_WAIT();
    const int c = lane & 7;
#pragma unroll
    for (int j = 0; j < 4; ++j) { const int n = (lane >> 3) + 8 * j; const LAS float* s = scr + (8 * c) * 33 + n;
        u32x4 o; o.x = cvt_pk_bf16(s[0 * 33], s[1 * 33]); o.y = cvt_pk_bf16(s[2 * 33], s[3 * 33]); o.z = cvt_pk_bf16(s[4 * 33], s[5 * 33]); o.w = cvt_pk_bf16(s[6 * 33], s[7 * 33]);
        *(u32x4*)(dst + (size_t)n * ldk + k0 + 8 * c) = o; }
    LDS_WAIT();
}
__device__ __forceinline__ int rowmap_gu(int n, int up) { return (n >> 7) * 256 + up * 128 + (n & 127); }
__device__ __forceinline__ int rowmap_in(int n) {
    if (n < 768 || n >= 1280) return n;
    if (n < 1024) { const int ch = n - 768; return 768 + (ch >> 7) * 256 + (ch & 127); }
    const int ch = n - 1024; return 768 + (ch >> 7) * 256 + 128 + (ch & 127);
}
template <bool HAS_D>
__device__ __forceinline__ void norm_row(const float* R, bf16* UD, float* H, const float* ga, float c, const float* gb, int lane, const bf16* P = nullptr, int nsl = 0) {
    f32x4 h[4];
#pragma unroll
    for (int j = 0; j < 4; ++j) h[j] = *(const f32x4*)(R + j * 256 + lane * 4);
    if (HAS_D) {
        f32x4 d[4]; float ss = 0.f;
#pragma unroll
        for (int j = 0; j < 4; ++j) { if (nsl == 0) d[j] = ld_bf4(UD + j * 256 + lane * 4); else { d[j] = ld_bf4(P + j * 256 + lane * 4); for (int s = 1; s < nsl; ++s) d[j] = d[j] + ld_bf4(P + (size_t)s * (1024 * 1024) + j * 256 + lane * 4); } ss += (d[j].x * d[j].x + d[j].y * d[j].y) + (d[j].z * d[j].z + d[j].w * d[j].w); }
        const float rstd = __builtin_amdgcn_rsqf(wave_sum(ss) * (1.f / DM) + RMS_EPS) * c;
#pragma unroll
        for (int j = 0; j < 4; ++j) { const f32x4 g = *(const f32x4*)(ga + j * 256 + lane * 4); h[j] = h[j] + d[j] * g * rstd; *(f32x4*)(H + j * 256 + lane * 4) = h[j]; }
    }
    if (gb) {
        float ss = 0.f;
#pragma unroll
        for (int j = 0; j < 4; ++j) ss += (h[j].x * h[j].x + h[j].y * h[j].y) + (h[j].z * h[j].z + h[j].w * h[j].w);
        const float rstd = __builtin_amdgcn_rsqf(wave_sum(ss) * (1.f / DM) + RMS_EPS);
#pragma unroll
        for (int j = 0; j < 4; ++j) { const f32x4 g = *(const f32x4*)(gb + j * 256 + lane * 4); st_bf4(UD + j * 256 + lane * 4, h[j] * g * rstd); }
    }
}

template <bool RBF> __device__ __forceinline__ f32x4 ld_res(const void* base, size_t off) { if (RBF) return ld_bf4((const bf16*)base + off); else return *(const f32x4*)((const float*)base + off); }
template <bool WF32> __device__ __forceinline__ void st_res(void* base, size_t off, f32x4 v) { if (WF32) *(f32x4*)((float*)base + off) = v; else st_bf4((bf16*)base + off, v); }
template <int NSL, bool RBF, bool WF32>
__device__ __forceinline__ void norm_phase(const void* Rp, const void* Rs, bf16* U, void* Hout, const bf16* P, const float* ga, float c, const float* gb, int gw, int ngw, int lane) {
    f32x4 gA[4], gB[4];
#pragma unroll
    for (int j = 0; j < 4; ++j) { gA[j] = *(const f32x4*)(ga + j * 256 + lane * 4) * c; gB[j] = gb ? *(const f32x4*)(gb + j * 256 + lane * 4) : (f32x4){0.f, 0.f, 0.f, 0.f}; }
    constexpr int RB = 2;
    const bool xloc = (ngw == 2048);
    const int rstep = xloc ? 256 : ngw, rbase = xloc ? ((gw >> 3) & 7) * 2048 + (gw >> 6) * 8 + (gw & 7) : gw, rend = xloc ? rbase + 2048 : MP;
#pragma unroll 1
    for (int row0 = rbase; row0 < rend; row0 += RB * rstep) {
        f32x4 h[RB][4], d[RB][4];
#pragma unroll
        for (int q = 0; q < RB; ++q) { const int row = row0 + q * rstep; if (row < rend) {
#pragma unroll
            for (int j = 0; j < 4; ++j) { h[q][j] = ld_res<RBF>(Rp, (size_t)row * DM + j * 256 + lane * 4); d[q][j] = ld_bf4(U + (size_t)row * DM + j * 256 + lane * 4); } } }
#pragma unroll
        for (int q = 0; q < RB; ++q) { const int row = row0 + q * rstep; if (row < rend) {
            float ss = 0.f;
#pragma unroll
            for (int j = 0; j < 4; ++j) ss += (d[q][j].x * d[q][j].x + d[q][j].y * d[q][j].y) + (d[q][j].z * d[q][j].z + d[q][j].w * d[q][j].w);
            const float rstd = __builtin_amdgcn_rsqf(wave_sum(ss) * (1.f / DM) + RMS_EPS);
            float s2 = 0.f;
#pragma unroll
            for (int j = 0; j < 4; ++j) { h[q][j] = h[q][j] + d[q][j] * gA[j] * rstd; st_res<WF32>(Hout, (size_t)row * DM + j * 256 + lane * 4, h[q][j]);
                s2 += (h[q][j].x * h[q][j].x + h[q][j].y * h[q][j].y) + (h[q][j].z * h[q][j].z + h[q][j].w * h[q][j].w); }
            if (gb) { const float r2 = __builtin_amdgcn_rsqf(wave_sum(s2) * (1.f / DM) + RMS_EPS);
#pragma unroll
                for (int j = 0; j < 4; ++j) st_bf4(U + (size_t)row * DM + j * 256 + lane * 4, h[q][j] * gB[j] * r2); } } }
    }
#pragma unroll 1
    for (int row = MP + gw; row < MTOK; row += ngw) {
        f32x4 h[4], d[4];
#pragma unroll
        for (int j = 0; j < 4; ++j) { h[j] = ld_res<RBF>(Rs, (size_t)(row - MP) * DM + j * 256 + lane * 4); d[j] = (f32x4){0.f, 0.f, 0.f, 0.f}; }
#pragma unroll
        for (int s = 0; s < NSL; ++s)
#pragma unroll
            for (int j = 0; j < 4; ++j) d[j] = d[j] + ld_bf4(P + (size_t)s * (1024 * 1024) + (size_t)(row - MP) * DM + j * 256 + lane * 4);
        float ss = 0.f;
#pragma unroll
        for (int j = 0; j < 4; ++j) ss += (d[j].x * d[j].x + d[j].y * d[j].y) + (d[j].z * d[j].z + d[j].w * d[j].w);
        const float rstd = __builtin_amdgcn_rsqf(wave_sum(ss) * (1.f / DM) + RMS_EPS);
        float s2 = 0.f;
#pragma unroll
        for (int j = 0; j < 4; ++j) { h[j] = h[j] + d[j] * gA[j] * rstd; st_res<WF32>(Hout, (size_t)row * DM + j * 256 + lane * 4, h[j]); s2 += (h[j].x * h[j].x + h[j].y * h[j].y) + (h[j].z * h[j].z + h[j].w * h[j].w); }
        if (gb) { const float r2 = __builtin_amdgcn_rsqf(wave_sum(s2) * (1.f / DM) + RMS_EPS);
#pragma unroll
            for (int j = 0; j < 4; ++j) st_bf4(U + (size_t)row * DM + j * 256 + lane * 4, h[j] * gB[j] * r2); }
    }
}
__device__ __forceinline__ unsigned hb_mask(int row, int ppu, int G) { const int T = (MTOK / 256) * 4 * ppu; unsigned m = 0u;
#pragma unroll
    for (int j = 0; j < 4; ++j) { const int un = (row >> 8) * 4 + j; const int c0 = ((un * ppu + 1) * G - 1) / T, c1 = (((un + 1) * ppu) * G - 1) / T; m |= (c0 != c1 ? 1u : 0u) << j; }
    return m; }
__device__ __forceinline__ const float* xrow(const Params& p, int row) { return row < MP ? p.in[I_XP] + (size_t)row * DM : p.in[I_XS] + (size_t)(row - MP) * DM; }


__device__ __forceinline__ void state_shift_copy(const Params& p, int l, int tix, int nthr) {
    constexpr int PER = 3840 + 3840 + 1408 + 448;
    for (int idx = tix; idx < NDB * PER; idx += nthr) { const int lb = l * NDB + idx / PER; int r = idx % PER; const float* src; float* dst;
        if (r < 3840) { src = p.in[I_SK] + (size_t)lb * 16384 + 1024 + r * 4; dst = p.out + O_KS + (size_t)lb * 16384 + r * 4; }
        else if (r < 7680) { r -= 3840; src = p.in[I_SV] + (size_t)lb * 16384 + 1024 + r * 4; dst = p.out + O_VS + (size_t)lb * 16384 + r * 4; }
        else if (r < 9088) { r -= 7680; src = p.in[I_SC] + (size_t)lb * 7680 + 2048 + r * 4; dst = p.out + O_CS + (size_t)lb * 7680 + r * 4; }
        else { r -= 9088; src = p.in[I_SP] + (size_t)lb * 3840 + 2048 + r * 4; dst = p.out + O_PS + (size_t)lb * 3840 + r * 4; }
        *(f32x4*)dst = *(const f32x4*)src; }
}

__device__ __forceinline__ void prologue(const Params& p, LAS unsigned char* lds, int gw, int ngw, int wave, int lane) {
    LAS float* scr = (LAS float*)(lds + wave * 16384);
    constexpr int I_FF = 16 * 88, I_WIN_N = 16 * 48, I_WO = 8 * 32, PER_L = 6 * I_FF + I_WIN_N + I_WO;
    for (int it = gw; it < DEPTH * PER_L; it += ngw) {
        const int l = it / PER_L; int r = it % PER_L;
        bf16* wl = (bf16*)(p.ws + WS_W + (size_t)l * W_LAYER);
        if (r < 6 * I_FF) {
            const int which = r / I_FF; r -= which * I_FF;
            const int half = which / 3, kind = which % 3;
            if (kind < 2) { const float* W = p.in[(half ? I_F2G : I_F1G) + kind] + (size_t)l * DM * DFF; const int kb = r / 88, nb = r % 88;
                bf16* dst = (bf16*)((unsigned char*)wl + (half ? W_GU2 : W_GU1)) + (size_t)rowmap_gu(nb * 32, kind) * DM;
                transpose_item(W, DFF, kb * 64, nb * 32, dst, DM, scr, lane); }
            else { const float* W = p.in[half ? I_F2D : I_F1D] + (size_t)l * DM * DFF; const int kb = r / 32, nb = r % 32;
                bf16* dst = (bf16*)((unsigned char*)wl + (half ? W_D2 : W_D1)) + (size_t)(nb * 32) * DFF;
                transpose_item(W, DM, kb * 64, nb * 32, dst, DFF, scr, lane); }
        } else if (r < 6 * I_FF + I_WIN_N) { r -= 6 * I_FF; const float* W = p.in[I_WIN] + (size_t)l * DM * NIN; const int kb = r / 48, nb = r % 48;
            bf16* dst = (bf16*)((unsigned char*)wl + W_IN) + (size_t)rowmap_in(nb * 32) * DM;
            transpose_item(W, NIN, kb * 64, nb * 32, dst, DM, scr, lane);
        } else { r -= 6 * I_FF + I_WIN_N; const float* W = p.in[I_WOUT] + (size_t)l * DM * DM; const int kb = r / 32, nb = r % 32;
            bf16* dst = (bf16*)((unsigned char*)wl + W_OUT) + (size_t)(nb * 32) * DM;
            transpose_item(W, DM, kb * 64, nb * 32, dst, DM, scr, lane); }
    }
    for (int fi0 = gw; fi0 < DEPTH * 1024; fi0 += ngw) {
        const int fi = (fi0 >= 2048) ? (fi0 ^ 512) : fi0;
        const int l = fi >> 10, kb = (fi & 1023) >> 4, n = (fi & 15) * 64 + lane;
        const float* wo = p.in[I_WOUT] + (size_t)l * DM * DM;
        float acc[8];
#pragma unroll
        for (int i = 0; i < 8; ++i) acc[i] = 0.f;
        if (kb < 32) {
            const float* pw = p.in[I_PW] + (size_t)l * 65536 + (size_t)(kb * 8) * 256; const float* wc = wo + (size_t)512 * DM + n;
#pragma unroll 1
            for (int j0 = 0; j0 < 256; j0 += 16) { float wv[16];
#pragma unroll
                for (int jj = 0; jj < 16; ++jj) wv[jj] = wc[(size_t)(j0 + jj) * DM];
#pragma unroll
                for (int jj = 0; jj < 16; ++jj)
#pragma unroll
                    for (int i = 0; i < 8; ++i) acc[i] += pw[i * 256 + j0 + jj] * wv[jj]; }
        } else {
            const int kk = (kb - 32) * 8, gi = kk >> 6, c0 = kk & 63;
            const float* pl = p.in[I_POOLW] + (size_t)l * 16384 + gi * 4096 + c0 * 64; const float* sc = p.in[I_PSC] + l * 256 + gi * 64; const float* wc = wo + (size_t)(768 + gi * 64) * DM + n;
#pragma unroll 1
            for (int d0 = 0; d0 < 64; d0 += 16) { float wv[16];
#pragma unroll
                for (int jj = 0; jj < 16; ++jj) wv[jj] = wc[(size_t)(d0 + jj) * DM] * sc[d0 + jj];
#pragma unroll
                for (int jj = 0; jj < 16; ++jj)
#pragma unroll
                    for (int i = 0; i < 8; ++i) acc[i] += pl[i * 64 + d0 + jj] * wv[jj]; }
        }
        u32x4 o; o.x = cvt_pk_bf16(acc[0], acc[1]); o.y = cvt_pk_bf16(acc[2], acc[3]); o.z = cvt_pk_bf16(acc[4], acc[5]); o.w = cvt_pk_bf16(acc[6], acc[7]);
        *(u32x4*)((bf16*)(p.ws + WS_W + (size_t)l * W_LAYER + W_OUT) + (size_t)n * DM + 512 + kb * 8) = o;
    }
    { float* wp = (float*)(p.ws + WS_WPAD); for (int idx = gw * 64 + lane; idx < DEPTH * 64 * 256; idx += ngw * 64) { const int l = idx >> 14, j = ((idx >> 8) & 63) - 15, c = idx & 255; wp[idx] = (j >= 0 && j <= 30) ? p.in[I_DWW][(size_t)l * 31 * 256 + j * 256 + c] : 0.f; } }
    bf16* U = (bf16*)(p.ws + WS_U);
    {
        f32x4 g0[4];
#pragma unroll
        for (int j = 0; j < 4; ++j) g0[j] = *(const f32x4*)(p.in[I_NG] + j * 256 + lane * 4);
#pragma unroll 1
        for (int row0 = gw; row0 < MTOK; row0 += 2 * ngw) {
            f32x4 h[2][4];
#pragma unroll
            for (int q = 0; q < 2; ++q) { const int row = row0 + q * ngw; if (row < MTOK) { const float* R = xrow(p, row);
#pragma unroll
                for (int j = 0; j < 4; ++j) h[q][j] = *(const f32x4*)(R + j * 256 + lane * 4); } }
#pragma unroll
            for (int q = 0; q < 2; ++q) { const int row = row0 + q * ngw; if (row < MTOK) { float ss = 0.f;
#pragma unroll
                for (int j = 0; j < 4; ++j) ss += (h[q][j].x * h[q][j].x + h[q][j].y * h[q][j].y) + (h[q][j].z * h[q][j].z + h[q][j].w * h[q][j].w);
                const float rstd = __builtin_amdgcn_rsqf(wave_sum(ss) * (1.f / DM) + RMS_EPS);
#pragma unroll
                for (int j = 0; j < 4; ++j) st_bf4(U + (size_t)row * DM + j * 256 + lane * 4, h[q][j] * g0[j] * rstd); } }
        }
    }
}

constexpr int KSTR = 72, VSTR = 264, KTILE = 256 * KSTR, VTILE = 64 * VSTR, VT_OFF = 2 * KTILE * 2;
static_assert(VT_OFF + 2 * VTILE * 2 <= LDS_BYTES, "attention LDS");
template <int NKB>
__device__ __forceinline__ void attn_wave(const LAS bf16* Ks, const LAS bf16* Vt, const bf16x8 qf0, const bf16x8 qf1, int qi, int j0, int lim, float slope, float sink, bf16* optr, int fr, int fq) {
    constexpr float LOG2E = 1.44269504f;
    bf16x8 qf[2]; qf[0] = qf0; qf[1] = qf1;
    f32x4 s[NKB];
#pragma unroll
    for (int kb = 0; kb < NKB; ++kb) { s[kb] = (f32x4){0.f, 0.f, 0.f, 0.f};
#pragma unroll
        for (int kc = 0; kc < 2; ++kc) { const bf16x8 a = *(const LAS bf16x8*)(Ks + (kb * 16 + fr) * KSTR + kc * 32 + fq * 8); s[kb] = __builtin_amdgcn_mfma_f32_16x16x32_bf16(a, qf[kc], s[kb], 0, 0, 0); } }
    const int base = qi + 128 - j0 - 4 * fq; const float slope2 = slope * LOG2E, b0 = -slope2 * (float)base, sink2 = sink * LOG2E;
    float mx = -1e30f;
#pragma unroll
    for (int kb = 0; kb < NKB; ++kb)
#pragma unroll
        for (int i = 0; i < 4; ++i) { const int c = kb * 16 + i; const bool valid = (unsigned)(base - c) < (unsigned)lim;
            const float lg = valid ? __builtin_fmaf(s[kb][i], 0.125f * LOG2E, __builtin_fmaf(slope2, (float)c, b0)) : -1e30f; s[kb][i] = lg; mx = fmaxf(mx, lg); }
    mx = fmaxf(mx, __shfl_xor(mx, 16)); mx = fmaxf(mx, __shfl_xor(mx, 32)); mx = fmaxf(mx, sink2);
    float sum = 0.f;
#pragma unroll
    for (int kb = 0; kb < NKB; ++kb)
#pragma unroll
        for (int i = 0; i < 4; ++i) { const float e = __builtin_amdgcn_exp2f(s[kb][i] - mx); s[kb][i] = e; sum += e; }
    sum += __shfl_xor(sum, 16); sum += __shfl_xor(sum, 32);
    const float inv = 1.0f / (sum + __builtin_amdgcn_exp2f(sink2 - mx));
    bf16x8 pf[NKB / 2];
#pragma unroll
    for (int kc = 0; kc < NKB / 2; ++kc) { u32x4 w; w.x = cvt_pk_bf16(s[2 * kc][0] * inv, s[2 * kc][1] * inv); w.y = cvt_pk_bf16(s[2 * kc][2] * inv, s[2 * kc][3] * inv);
        w.z = cvt_pk_bf16(s[2 * kc + 1][0] * inv, s[2 * kc + 1][1] * inv); w.w = cvt_pk_bf16(s[2 * kc + 1][2] * inv, s[2 * kc + 1][3] * inv); pf[kc] = __builtin_bit_cast(bf16x8, w); }
#pragma unroll
    for (int db = 0; db < 4; ++db) { f32x4 o = (f32x4){0.f, 0.f, 0.f, 0.f};
#pragma unroll
        for (int kc = 0; kc < NKB / 2; ++kc) { const LAS bf16* vp = Vt + (db * 16 + fr) * VSTR + kc * 32 + 4 * fq;
            const u32x2 lo = *(const LAS u32x2*)vp, hi = *(const LAS u32x2*)(vp + 16); u32x4 a; a.x = lo.x; a.y = lo.y; a.z = hi.x; a.w = hi.y;
            o = __builtin_amdgcn_mfma_f32_16x16x32_bf16(__builtin_bit_cast(bf16x8, a), pf[kc], o, 0, 0, 0); }
        st_bf4_mfma(optr + db * 16 + 4 * fq, o); }
}


template <bool SAMP, int NT>
__device__ __forceinline__ void convpool_unit(const Params& p, const bf16* Z, bf16* MIX, int l, int row0, int b, int t0, int lane_in) {
    int lane = lane_in; asm volatile("" : "+v"(lane));
    const int ch = lane * 4;
    const f32x4 zero4 = (f32x4){0.f, 0.f, 0.f, 0.f};
    {
        const float* dw = (const float*)(p.ws + WS_WPAD) + (size_t)l * 64 * 256 + 15 * 256 + ch;
        const float* sc = p.in[I_SC] + (size_t)(l * NDB + b) * 30 * 256 + ch;
        const bf16* zg = Z + (size_t)(SAMP ? MP + b * DSEQ : b * SEQ) * ZLD + 768 + ch;
        constexpr int NROW = 30 + NT, NRB = (NROW + 7) / 8 * 8;
        f32x4 acc[NT];
#pragma unroll
        for (int tt = 0; tt < NT; ++tt) acc[tt] = zero4;
        u32x2 nv[8];
        if (!SAMP) {
#pragma unroll
            for (int i = 0; i < 8; ++i) { const int t = t0 + i - 30, tc = t < 0 ? 0 : t; nv[i] = *(const u32x2*)(zg + (size_t)tc * ZLD); } }
#pragma unroll 1
        for (int r0 = 0; r0 < NRB; r0 += 8) {
            f32x4 val[8];
#pragma unroll
            for (int i = 0; i < 8; ++i) { const int r = r0 + i;
                if (SAMP) { const int rs = r < 29 ? r : 29, rz = r < 30 ? 0 : (r > 37 ? 7 : r - 30); const f32x4 a = *(const f32x4*)(sc + rs * 256), z = ld_bf4(zg + (size_t)rz * ZLD); val[i] = r < 30 ? a : z; }
                else { const int t = t0 + r - 30; f32x4 z; z.x = __uint_as_float(nv[i].x << 16); z.y = __uint_as_float(nv[i].x & 0xffff0000u); z.z = __uint_as_float(nv[i].y << 16); z.w = __uint_as_float(nv[i].y & 0xffff0000u); val[i] = t >= 0 ? z : zero4; } }
            if (!SAMP) {
#pragma unroll
                for (int i = 0; i < 8; ++i) { const int t = t0 + r0 + 8 + i - 30, tc = t < 0 ? 0 : (t > SEQ - 1 ? SEQ - 1 : t); nv[i] = *(const u32x2*)(zg + (size_t)tc * ZLD); } }
#pragma unroll
            for (int hh = 0; hh < NT / 8; ++hh) {
                f32x4 wb[15];
#pragma unroll
                for (int k = 0; k < 15; ++k) wb[k] = *(const f32x4*)(dw + (r0 - 8 * hh - 7 + k) * 256);
#pragma unroll
                for (int i = 0; i < 8; ++i)
#pragma unroll
                    for (int tt = 0; tt < 8; ++tt) acc[8 * hh + tt] += wb[i - tt + 7] * val[i];
            }
#pragma unroll
            for (int i = 0; i < 8; ++i) { const int r = r0 + i; if (r >= 30 && r < NROW) { const int tok = r - 30;
                if (SAMP) *(f32x4*)(p.out + O_CS + ((size_t)(l * NDB + b) * 30 + 22 + tok) * 256 + ch) = val[i];
                else if (t0 + tok >= SEQ - 30) *(f32x4*)(p.out + O_CP + ((size_t)(l * NB + b) * 30 + (t0 + tok - (SEQ - 30))) * 256 + ch) = val[i]; } }
        }
        const f32x4 bias = *(const f32x4*)(p.in[I_DWB] + l * 256 + ch), lg = *(const f32x4*)(p.in[I_LNG] + l * 256 + ch), lb = *(const f32x4*)(p.in[I_LNB] + l * 256 + ch);
#pragma unroll
        for (int tt = 0; tt < NT; ++tt) { const f32x4 c = acc[tt] + bias; const float mean = wave_sum((c.x + c.y) + (c.z + c.w)) * (1.f / 256.f); const f32x4 d = c - mean;
            const float var = wave_sum((d.x * d.x + d.y * d.y) + (d.z * d.z + d.w * d.w)) * (1.f / 256.f); const float rstd = __builtin_amdgcn_rsqf(var + LN_EPS);
            f32x4 y = d * rstd * lg + lb; y.x *= pg8::sigmoidf_fast(y.x); y.y *= pg8::sigmoidf_fast(y.y); y.z *= pg8::sigmoidf_fast(y.z); y.w *= pg8::sigmoidf_fast(y.w);
            st_bf4(MIX + (size_t)(row0 + tt) * DM + 512 + ch, y); }
    }
    {
        const int wsz = 2 << (lane >> 4);
        const float f4 = wsz >= 4 ? 1.f : 0.f, f8 = wsz >= 8 ? 1.f : 0.f, f16 = wsz >= 16 ? 1.f : 0.f;
        const float* sp = p.in[I_SP] + (size_t)(l * NDB + b) * 15 * 256 + ch;
        const bf16* zp = Z + (size_t)(SAMP ? MP + b * DSEQ : b * SEQ) * ZLD + 1024 + ch;
        constexpr int NROW = 15 + NT, NRB = (NROW + 7) / 8 * 8;
        f32x4 acc[NT];
#pragma unroll
        for (int tt = 0; tt < NT; ++tt) acc[tt] = zero4;
#pragma unroll
        for (int r0 = 0; r0 < NRB; r0 += 8) {
            f32x4 val[8];
#pragma unroll
            for (int i = 0; i < 8; ++i) { const int r = r0 + i;
                if (SAMP) { const int rs = r < 14 ? r : 14, rz = r < 15 ? 0 : (r > 22 ? 7 : r - 15); if (r < 15) val[i] = *(const f32x4*)(sp + rs * 256); else val[i] = ld_bf4(zp + (size_t)rz * ZLD); }
                else { const int t = t0 + r - 15, tc = t < 0 ? 0 : (t > SEQ - 1 ? SEQ - 1 : t); const f32x4 z = ld_bf4(zp + (size_t)tc * ZLD); val[i] = t >= 0 ? z : zero4; } }
#pragma unroll
            for (int i = 0; i < 8; ++i)
#pragma unroll
                for (int tt = 0; tt < NT; ++tt) { const int ii = 15 + tt - (r0 + i);
                    if (ii == 0) { const int pos = SAMP ? 8192 + tt : t0 + tt; const int cnt = wsz < pos + 1 ? wsz : pos + 1; acc[tt] += val[i] * (1.f - (float)cnt); }
                    else if (ii == 1) acc[tt] += val[i];
                    else if (ii >= 2 && ii < 4) acc[tt] += val[i] * f4;
                    else if (ii >= 4 && ii < 8) acc[tt] += val[i] * f8;
                    else if (ii >= 8 && ii < 16) acc[tt] += val[i] * f16; }
#pragma unroll
            for (int i = 0; i < 8; ++i) { const int r = r0 + i; if (r >= 15 && r < NROW) { const int tok = r - 15;
                if (SAMP) *(f32x4*)(p.out + O_PS + ((size_t)(l * NDB + b) * 15 + 7 + tok) * 256 + ch) = val[i];
                else if (t0 + tok >= SEQ - 15) *(f32x4*)(p.out + O_PP + ((size_t)(l * NB + b) * 15 + (t0 + tok - (SEQ - 15))) * 256 + ch) = val[i]; } }
            asm volatile("" ::: "memory");
        }
#pragma unroll
        for (int tt = 0; tt < NT; ++tt) { const int pos = SAMP ? 8192 + tt : t0 + tt; const int cnt = wsz < pos + 1 ? wsz : pos + 1; const float ic = 1.0f / (float)cnt;
            st_bf4(MIX + (size_t)(row0 + tt) * DM + 768 + ch, acc[tt] * ic); }
    }
}

__device__ __forceinline__ void mixer_phase(const Params& p, LAS unsigned char* lds, int l, int gw, int ngw, int wave, int lane, int tid) {
    const bf16* Z = (const bf16*)(p.ws + WS_Z); bf16* MIX = (bf16*)(p.ws + WS_MIX);
    LAS bf16* Ks = (LAS bf16*)lds; LAS bf16* Vt = (LAS bf16*)(lds + VT_OFF);
    const int fr = lane & 15, fq = lane >> 4;
    const float* sinks = p.in[I_SINK] + l * 8;
    for (int uid = blockIdx.x; uid < 256 + NDB; uid += gridDim.x) {
        __syncthreads();
        if (uid < 256) {
            const int pu = (gridDim.x == 256) ? ((uid & 7) * 32 + (uid >> 3)) : uid;
            const int b = pu >> 5, qb = (pu >> 1) & 15, kv = pu & 1;
            u32x4 k4s[4], v4s[4];
#pragma unroll
            for (int it = 0; it < 4; ++it) { const int c = tid + it * 512, j = c >> 3, dc = (c & 7) * 8, t = qb * 128 - 128 + j;
                k4s[it] = (u32x4){0u, 0u, 0u, 0u}; v4s[it] = k4s[it];
                if (t >= 0) { const bf16* zr = Z + (size_t)(b * SEQ + t) * ZLD; k4s[it] = *(const u32x4*)(zr + 512 + kv * 64 + dc); v4s[it] = *(const u32x4*)(zr + 640 + kv * 64 + dc); } }
#pragma unroll
            for (int it = 0; it < 4; ++it) { const int c = tid + it * 512, j = c >> 3, dc = (c & 7) * 8; const u32x4 k4 = k4s[it], v4 = v4s[it];
                *(LAS u32x4*)(Ks + j * KSTR + dc) = k4;
                const unsigned vv[4] = {v4.x, v4.y, v4.z, v4.w};
#pragma unroll
                for (int e = 0; e < 4; ++e) { Vt[(dc + 2 * e) * VSTR + j] = (bf16)(vv[e] & 0xffffu); Vt[(dc + 2 * e + 1) * VSTR + j] = (bf16)(vv[e] >> 16); }
                if (qb == 15 && j >= 128) { const size_t o = ((size_t)(l * NB + b) * 128 + (j - 128)) * 128 + kv * 64 + dc; float* ko = p.out + O_KP + o; float* vo = p.out + O_VP + o;
                    const unsigned kk[4] = {k4.x, k4.y, k4.z, k4.w};
                    *(f32x4*)ko = (f32x4){__uint_as_float(kk[0] << 16), __uint_as_float(kk[0] & 0xffff0000u), __uint_as_float(kk[1] << 16), __uint_as_float(kk[1] & 0xffff0000u)};
                    *(f32x4*)(ko + 4) = (f32x4){__uint_as_float(kk[2] << 16), __uint_as_float(kk[2] & 0xffff0000u), __uint_as_float(kk[3] << 16), __uint_as_float(kk[3] & 0xffff0000u)};
                    *(f32x4*)vo = (f32x4){__uint_as_float(vv[0] << 16), __uint_as_float(vv[0] & 0xffff0000u), __uint_as_float(vv[1] << 16), __uint_as_float(vv[1] & 0xffff0000u)};
                    *(f32x4*)(vo + 4) = (f32x4){__uint_as_float(vv[2] << 16), __uint_as_float(vv[2] & 0xffff0000u), __uint_as_float(vv[3] << 16), __uint_as_float(vv[3] & 0xffff0000u)}; }
            }
            __syncthreads();
            const int g = wave >> 1, h = kv * 4 + g; const float slope = __builtin_amdgcn_exp2f(-(float)(h + 1)), sink = sinks[h];
            const bf16* qp0 = Z + ((size_t)b * SEQ + qb * 128 + (wave & 1) * 64 + fr) * ZLD + h * 64 + fq * 8;
            bf16x8 q0 = *(const bf16x8*)qp0, q1 = *(const bf16x8*)(qp0 + 32);
#pragma unroll 1
            for (int qq = 0; qq < 4; ++qq) { const int qi = (wave & 1) * 64 + qq * 16 + fr; const size_t row = (size_t)b * SEQ + qb * 128 + qi;
                const bf16* qn = qp0 + (size_t)((qq + 1) & 3) * 16 * ZLD; const bf16x8 n0 = *(const bf16x8*)qn, n1 = *(const bf16x8*)(qn + 32);
                const int j0 = (((wave & 1) * 4 + qq) & ~1) * 16;
                attn_wave<10>(Ks + j0 * KSTR, Vt + j0, q0, q1, qi, j0, qb == 0 ? qi + 1 : 128, slope, sink, MIX + row * DM + h * 64, fr, fq); q0 = n0; q1 = n1; }
        } else {
            const int b = uid - 256;
            for (int c = tid; c < 160 * 16; c += 512) { const int j = c >> 4, kvh = (c >> 3) & 1, dc = (c & 7) * 8;
                u32x4 k4 = (u32x4){0u, 0u, 0u, 0u}, v4 = k4;
                if (j < 128) { const size_t o = ((size_t)(l * NDB + b) * 128 + j) * 128 + kvh * 64 + dc; const float* ks = p.in[I_SK] + o; const float* vs = p.in[I_SV] + o;
                    const f32x4 a0 = *(const f32x4*)ks, a1 = *(const f32x4*)(ks + 4), b0 = *(const f32x4*)vs, b1 = *(const f32x4*)(vs + 4);
                    k4.x = cvt_pk_bf16(a0.x, a0.y); k4.y = cvt_pk_bf16(a0.z, a0.w); k4.z = cvt_pk_bf16(a1.x, a1.y); k4.w = cvt_pk_bf16(a1.z, a1.w);
                    v4.x = cvt_pk_bf16(b0.x, b0.y); v4.y = cvt_pk_bf16(b0.z, b0.w); v4.z = cvt_pk_bf16(b1.x, b1.y); v4.w = cvt_pk_bf16(b1.z, b1.w); }
                else if (j < 136) { const bf16* zr = Z + (size_t)(MP + b * DSEQ + (j - 128)) * ZLD; k4 = *(const u32x4*)(zr + 512 + kvh * 64 + dc); v4 = *(const u32x4*)(zr + 640 + kvh * 64 + dc);
                    const size_t o = ((size_t)(l * NDB + b) * 128 + 120 + (j - 128)) * 128 + kvh * 64 + dc; float* ko = p.out + O_KS + o; float* vo = p.out + O_VS + o;
                    const unsigned kk[4] = {k4.x, k4.y, k4.z, k4.w}, vv2[4] = {v4.x, v4.y, v4.z, v4.w};
                    *(f32x4*)ko = (f32x4){__uint_as_float(kk[0] << 16), __uint_as_float(kk[0] & 0xffff0000u), __uint_as_float(kk[1] << 16), __uint_as_float(kk[1] & 0xffff0000u)};
                    *(f32x4*)(ko + 4) = (f32x4){__uint_as_float(kk[2] << 16), __uint_as_float(kk[2] & 0xffff0000u), __uint_as_float(kk[3] << 16), __uint_as_float(kk[3] & 0xffff0000u)};
                    *(f32x4*)vo = (f32x4){__uint_as_float(vv2[0] << 16), __uint_as_float(vv2[0] & 0xffff0000u), __uint_as_float(vv2[1] << 16), __uint_as_float(vv2[1] & 0xffff0000u)};
                    *(f32x4*)(vo + 4) = (f32x4){__uint_as_float(vv2[2] << 16), __uint_as_float(vv2[2] & 0xffff0000u), __uint_as_float(vv2[3] << 16), __uint_as_float(vv2[3] & 0xffff0000u)}; }
                *(LAS u32x4*)(Ks + kvh * KTILE + j * KSTR + dc) = k4;
                const unsigned vv[4] = {v4.x, v4.y, v4.z, v4.w};
#pragma unroll
                for (int e = 0; e < 4; ++e) { Vt[kvh * VTILE + (dc + 2 * e) * VSTR + j] = (bf16)(vv[e] & 0xffffu); Vt[kvh * VTILE + (dc + 2 * e + 1) * VSTR + j] = (bf16)(vv[e] >> 16); }
            }
            __syncthreads();
            if (wave < 4) { const int kvh = wave >> 1, rr = (wave & 1) * 16 + fr, qi = rr & 7, h = kvh * 4 + (rr >> 3);
                const float slope = __builtin_amdgcn_exp2f(-(float)(h + 1)), sink = sinks[h]; const size_t row = (size_t)MP + b * DSEQ + qi;
                const bf16* qp = Z + row * ZLD + h * 64;
                attn_wave<10>(Ks + kvh * KTILE, Vt + kvh * VTILE, *(const bf16x8*)(qp + fq * 8), *(const bf16x8*)(qp + 32 + fq * 8), qi, 0, 128, slope, sink, MIX + row * DM + h * 64, fr, fq); }
        }
    }
    if (ngw == 2048) {
        if (blockIdx.x >= 128) { const int unit = ((int)blockIdx.x & 7) * 128 + (((int)blockIdx.x - 128) >> 3) * 8 + wave;     convpool_unit<false, 16>(p, Z, MIX, l, unit * 16, unit >> 7, (unit & 127) * 16, lane); }
        else if (wave == 4) { const int sb = (int)blockIdx.x; convpool_unit<true, 8>(p, Z, MIX, l, MP + sb * 8, sb, 0, lane); }
    } else {
        for (int unit = gw; unit < MP / 16 + NDB; unit += ngw) {
            if (unit < MP / 16) convpool_unit<false, 16>(p, Z, MIX, l, unit * 16, unit >> 7, (unit & 127) * 16, lane);
            else convpool_unit<true, 8>(p, Z, MIX, l, MP + (unit - MP / 16) * 8, unit - MP / 16, 0, lane);
        }
    }
}

#define XB_TMO      128
#define XB_XCNT(j)  (256  + 64 * (j))
#define XB_XSUB(j)  (1280 + 64 * (j))
#define XB_XGEN(j)  (2304 + 64 * (j))
#define XB_TOP      3328
#define XB_TOPGEN   3392
#define XCD_BAR_WORDS 3456
#define XB_SPIN_CAP (1u << 18)
__device__ __forceinline__ unsigned xb_ld(unsigned* p)              { return __hip_atomic_load(p, __ATOMIC_RELAXED, __HIP_MEMORY_SCOPE_AGENT); }
__device__ __forceinline__ unsigned xb_add(unsigned* p, unsigned v) { return __hip_atomic_fetch_add(p, v, __ATOMIC_RELAXED, __HIP_MEMORY_SCOPE_AGENT); }
__device__ __forceinline__ unsigned xb_xcc_id() { return (unsigned)__builtin_amdgcn_s_getreg((3 << 11) | 20) & 0xFu; }
#define XB_SPIN(cond, bar) do { unsigned _sp = 0; while (cond) { __builtin_amdgcn_s_sleep(1); \
    if ((++_sp & 255u) == 0u) { if (xb_ld(&(bar)[XB_TMO])) break; if (_sp > XB_SPIN_CAP) { atomicAdd(&(bar)[XB_TMO], 1u); break; } } } } while (0)
struct XcdBarrier { unsigned* bar; unsigned x; volatile LAS unsigned* st; };
__device__ __forceinline__ XcdBarrier xcd_barrier_post(unsigned* bar, volatile LAS unsigned* st) {
    XcdBarrier b; b.bar = bar; b.x = xb_xcc_id(); b.st = st;
    if (threadIdx.x == 0) (void)xb_add(&bar[XB_XCNT(b.x)], 1u);
    return b;
}
__device__ __forceinline__ void xcd_barrier_complete(unsigned* bar, unsigned x, unsigned& nloc, unsigned& nx) {
    const unsigned G = gridDim.x * gridDim.y * gridDim.z;
    unsigned sum, cnt, mine, sp = 0u;
    for (;;) {
        sum = 0u; cnt = 0u; mine = 0u;
#pragma unroll
        for (unsigned j = 0; j < 16; ++j) { const unsigned c = xb_ld(&bar[XB_XCNT(j)]); sum += c; cnt += (c > 0u) ? 1u : 0u; mine = (j == x) ? c : mine; }
        if (sum == G) break;
        __builtin_amdgcn_s_sleep(1);
        if ((++sp & 255u) == 0u) { if (xb_ld(&bar[XB_TMO])) break; if (sp > XB_SPIN_CAP) { atomicAdd(&bar[XB_TMO], 1u); break; } }
    }
    nloc = mine > 0u ? mine : 1u; nx = cnt > 0u ? cnt : 1u;
}
__device__ __forceinline__ void xcd_barrier(const XcdBarrier& b) {
    asm volatile("s_waitcnt vmcnt(0)" ::: "memory");
    __syncthreads();
    if (threadIdx.x == 0) {
        unsigned* bar = b.bar;
        __builtin_amdgcn_s_waitcnt(0);
        unsigned nloc = b.st[0], nx = b.st[1];
        if (nloc == 0u) { xcd_barrier_complete(bar, b.x, nloc, nx); b.st[0] = nloc; b.st[1] = nx; }
        const unsigned old = xb_add(&bar[XB_XSUB(b.x)], 1u);
        const unsigned gen = old / nloc;
        if (old + 1u == (gen + 1u) * nloc) {
            __builtin_amdgcn_fence(__ATOMIC_RELEASE, "agent");
            asm volatile("s_waitcnt vmcnt(0)" ::: "memory");
            const unsigned og = xb_add(&bar[XB_TOP], 1u);
            const unsigned tg = og / nx;
            if (og + 1u == (tg + 1u) * nx) xb_add(&bar[XB_TOPGEN], 1u);
            else XB_SPIN(xb_ld(&bar[XB_TOPGEN]) == tg, bar);
            __builtin_amdgcn_fence(__ATOMIC_ACQUIRE, "agent");
            xb_add(&bar[XB_XGEN(b.x)], 1u);
            asm volatile("s_waitcnt vmcnt(0)" ::: "memory");
        } else {
            XB_SPIN(xb_ld(&bar[XB_XGEN(b.x)]) == gen, bar);
            __builtin_amdgcn_fence(__ATOMIC_ACQUIRE, "agent");
            asm volatile("s_waitcnt vmcnt(0)" ::: "memory");
        }
    }
    __syncthreads();
}

__global__ void __launch_bounds__(512, 2) mega_fwd(Params p) {
    extern __shared__ __attribute__((aligned(16))) unsigned char lds_raw[];
    LAS unsigned char* lds = (LAS unsigned char*)lds_raw;
    cg::grid_group grid = cg::this_grid();
    const int lo = p.ph_lo, hi = p.ph_hi;
    const int ngw = gridDim.x * 8;
    unsigned* barw = (unsigned*)p.ws;
    volatile LAS unsigned* bst = (volatile LAS unsigned*)(lds + LDS_BYTES - 16);
    if (threadIdx.x == 0) { bst[0] = 0u; bst[1] = 0u; }
    __syncthreads();
    XcdBarrier xbar = xcd_barrier_post(barw, bst);
    if (hi == -12345) grid.sync();
    const float one = p.one;
#define FRESH() int tid_ = threadIdx.x; asm volatile("" : "+v"(tid_)); const int lane = tid_ & 63, wave = __builtin_amdgcn_readfirstlane(tid_ >> 6), gw = blockIdx.x * 8 + wave
#define IN(k) (lo <= (k) && (k) < hi)
#define SEAM(k) do { if (lo <= (k) && (k) + 1 < hi) { xcd_barrier(xbar); if (MK_DUP & 64) xcd_barrier(xbar); } } while (0)
    bf16* U = (bf16*)(p.ws + WS_U); bf16* ACT = (bf16*)(p.ws + WS_ACT); bf16* Zb = (bf16*)(p.ws + WS_Z); bf16* MIX = (bf16*)(p.ws + WS_MIX);
    float* H = p.out; const bf16* D1b = (const bf16*)(p.ws + WS_D1); bf16* Hb = (bf16*)(p.ws + WS_HB);
    const int vcu = (gridDim.x % 8 == 0) ? (int)(blockIdx.x % 8) * (int)(gridDim.x / 8) + (int)(blockIdx.x / 8) : (int)blockIdx.x;
    if (IN(0)) REP(1) { FRESH(); prologue(p, lds, gw, ngw, wave, lane); }
    SEAM(0);
#pragma unroll 1
    for (int l = 0; l < DEPTH; ++l) {
        const int pb = 1 + 10 * l;
        const unsigned char* wl = p.ws + WS_W + (size_t)l * W_LAYER;
        const float* ng = p.in[I_NG] + (size_t)l * 6 * DM;
#pragma unroll 1
        for (int half = 0; half < 2; ++half) {
            const int hb = pb + (half ? 7 : 0);
            if (IN(hb)) REP(2) {
                pg8::Gemm g{U, (const bf16*)(wl + (half ? W_GU2 : W_GU1)), MTOK, NGU, DM}; pg8::StaticOrder S; S.init(MTOK, NGU, gridDim.x, blockIdx.x);
                pg8::EpiSwiGLU E{ACT, DFF};
                pg8::gemm_phase<pg8::EpiSwiGLU, pg8::StaticOrder, true, true>(lds, g, S, E);
            }
            SEAM(hb);
            if (IN(hb + 1)) REP(4) {
                pg8::Gemm g{ACT, (const bf16*)(wl + (half ? W_D2 : W_D1)), MTOK, DM, DFF}; pg8::HybridOrder S; S.init(DFF, gridDim.x, blockIdx.x);
                pg8::EpiPlain E{U, DM, one, (WS_D1 - WS_U) / 2};
                pg8::gemm_phase<pg8::EpiPlain, pg8::HybridOrder, true, true>(lds, g, S, E);
            }
            SEAM(hb + 1);
            if (IN(hb + 2)) {
                FRESH();
                const float* ga = ng + (half ? 5 : 1) * DM; const float* gb = half ? (l + 1 < DEPTH ? ng + 6 * DM : nullptr) : ng + 2 * DM;
                if (l == 0 && half == 0) norm_phase<16, false, false>(p.in[I_XP], p.in[I_XS], U, Hb, D1b, ga, 0.5f, gb, gw, ngw, lane);
                else if (l == DEPTH - 1 && half == 1) norm_phase<16, true, true>(Hb, Hb + (size_t)MP * DM, U, H, D1b, ga, 0.5f, gb, gw, ngw, lane);
                else norm_phase<16, true, false>(Hb, Hb + (size_t)MP * DM, U, Hb, D1b, ga, 0.5f, gb, gw, ngw, lane);
            }
            SEAM(hb + 2);
            if (half == 0) {
                if (IN(pb + 3)) REP(8) {
                    pg8::Gemm g{U, (const bf16*)(wl + W_IN), MTOK, NIN, DM}; pg8::StaticOrder S; S.init(MTOK, NIN, gridDim.x, blockIdx.x);
                    pg8::EpiZ E{Zb, ZLD, one};
                    pg8::gemm_phase<pg8::EpiZ, pg8::StaticOrder, true, true>(lds, g, S, E);
                    { constexpr int NU = (MTOK / 256) * (NIN / 256); const int nfull = NU % (int)gridDim.x;
                      FRESH(); if (rep_ == 0) { if (nfull > 0 && (int)blockIdx.x >= nfull) state_shift_copy(p, l, ((int)blockIdx.x - nfull) * 512 + tid_, ((int)gridDim.x - nfull) * 512); else if (nfull == 0) state_shift_copy(p, l, (int)blockIdx.x * 512 + tid_, (int)gridDim.x * 512); } (void)lane; (void)wave; (void)gw; }
                }
                SEAM(pb + 3);
                if (IN(pb + 4)) REP(16) { FRESH(); mixer_phase(p, lds, l, gw, ngw, wave, lane, tid_); }
                SEAM(pb + 4);
                if (IN(pb + 5)) REP(32) {
                    pg8::Gemm g{MIX, (const bf16*)(wl + W_OUT), MTOK, DM, DM}; pg8::HybridOrder S; S.init(DM, gridDim.x, blockIdx.x);
                    pg8::EpiPlain E{U, DM, one, (WS_D1 - WS_U) / 2};
                    pg8::gemm_phase<pg8::EpiPlain, pg8::HybridOrder, true, true>(lds, g, S, E);
                }
                SEAM(pb + 5);
                if (IN(pb + 6)) {
                    FRESH();
                    norm_phase<8, true, false>(Hb, Hb + (size_t)MP * DM, U, Hb, D1b, ng + 3 * DM, 1.0f, ng + 4 * DM, gw, ngw, lane);
                }
                SEAM(pb + 6);
            }
        }
    }
#undef IN
#undef SEAM
#undef FRESH
}

extern "C" void kernel_launch(void* const* d_in, const int* in_sizes, int n_in, void* d_out, int out_size, void* d_ws, size_t ws_size, hipStream_t stream) {
    static int grid = 0;
    if (grid == 0) {
        if (n_in != 23 || (size_t)out_size != O_END || ws_size < WS_END) { fprintf(stderr, "kernel_launch: unexpected shapes: n_in %d out %d ws %zu\n", n_in, out_size, ws_size); grid = -1; return; }
        int dev = 0, cus = 0, per_cu = 0;
        hipGetDevice(&dev); hipDeviceGetAttribute(&cus, hipDeviceAttributeMultiprocessorCount, dev);
        if (hipFuncSetAttribute((const void*)mega_fwd, hipFuncAttributeMaxDynamicSharedMemorySize, LDS_BYTES) != hipSuccess) { fprintf(stderr, "kernel_launch: hipFuncSetAttribute failed\n"); grid = -1; return; }
        if (hipOccupancyMaxActiveBlocksPerMultiprocessor(&per_cu, (const void*)mega_fwd, 512, LDS_BYTES) != hipSuccess || per_cu < 1) { fprintf(stderr, "kernel_launch: occupancy query says %d\n", per_cu); per_cu = 1; }
        (void)hipGetLastError();
        grid = cus * 1;
        if (grid != 256) { fprintf(stderr, "kernel_launch: built for a 256-CU device (hybrid split-K order); got %d\n", grid); grid = -1; return; }
        fprintf(stderr, "kernel_launch: grid %d (cus %d, per_cu %d)\n", grid, cus, per_cu);
    }
    if (grid < 0) return;
    if (hipMemsetAsync(d_ws, 0, 16384, stream) != hipSuccess) { fprintf(stderr, "kernel_launch: memset of the barrier words failed\n"); return; }
    Params a{};
    for (int i = 0; i < 23; ++i) a.in[i] = (const float*)d_in[i];
    a.out = (float*)d_out; a.ws = (unsigned char*)d_ws; a.one = 1.0f;
#if MK_MULTI_LAUNCH
    for (int k = 0; k < NPH; ++k) { a.ph_lo = k; a.ph_hi = k + 1; hipLaunchKernelGGL(mega_fwd, dim3(grid), dim3(512), LDS_BYTES, stream, a); }
#else
    a.ph_lo = 0; a.ph_hi = NPH;
    void* args[] = {&a};
    hipError_t e = hipLaunchCooperativeKernel((const void*)mega_fwd, dim3(grid), dim3(512), args, LDS_BYTES, stream);
    if (e != hipSuccess) fprintf(stderr, "kernel_launch: cooperative launch failed: %s (grid %d)\n", hipGetErrorString(e), grid);
#endif
}
```

```cpp
#include <hip/hip_runtime.h>
#include <hip/hip_cooperative_groups.h>
#include <cstdio>
#include <cstdint>
namespace cg = cooperative_groups;
#ifndef MK_MULTI_LAUNCH
#define MK_MULTI_LAUNCH 0
#endif
namespace pg8 {
#define PG8_LAS __attribute__((address_space(3)))
typedef unsigned short bf16_t;
typedef short bf16x8 __attribute__((ext_vector_type(8)));
typedef float f32x4 __attribute__((ext_vector_type(4)));
typedef unsigned u32x4 __attribute__((ext_vector_type(4)));
constexpr int BM = 256, BK = 64, HALF = 128, HTB = HALF * BK * 2  , STAGE_BYTES = 8 * HTB, NXCD = 8, WGM = 8;

__host__ __device__ __forceinline__ int lds_byte(int r, int c) { const int st = (r >> 4) * 2 + (c >> 5), rr = r & 15, cc = c & 31, ob = rr * 64 + cc * 2; return st * 1024 + (ob ^ (((ob >> 9) & 1) << 5)); }
__host__ __device__ __forceinline__ void stage_rc(int b, int& R, int& C) { const int st = b / 1024, sb = b % 1024, swz = sb ^ (((sb >> 9) & 1) << 5); R = (st >> 1) * 16 + swz / 64; C = (st & 1) * 32 + (swz % 64) / 2; }
__host__ __device__ __forceinline__ int perm32(int rho) { const int n = rho >> 4, i = rho & 15; return 8 * (i >> 2) + 4 * n + (i & 3); }

struct Unit { int pm, pn, k0, nk, which; };
struct Gemm { const bf16_t* A; const bf16_t* Bt; int M, N, K; };

struct StaticOrder {
    static constexpr bool SPLITK = false;
    int nM, nN, nwg, G, c;
    __host__ __device__ void init(int M, int N, int G_, int c_) { nM = M / BM; nN = N / BM; nwg = nM * nN; G = G_; c = c_; }
    __host__ __device__ bool next(int i, Unit& u) const {
        const long L = (long)i * G + c; if (L >= nwg) return false;
        int wgid = (int)L; { const int q = nwg / NXCD, r = nwg % NXCD, xcd = wgid % NXCD, off = wgid / NXCD; wgid = (xcd < r ? xcd * (q + 1) : r * (q + 1) + (xcd - r) * q) + off; }
        const int nig = WGM * nN, gid = wgid / nig, fm = gid * WGM, gsz = (nM - fm) < WGM ? (nM - fm) : WGM;
        u.pm = fm + ((wgid % nig) % gsz); u.pn = (wgid % nig) / gsz; return true;
    }
    __device__ __forceinline__ void a_ready(const Unit&) const {}
    __device__ __forceinline__ void done(const Unit&) const {}
};

struct StreamKOrder {
    static constexpr bool SPLITK = true;
    int nN, ppu, G, lo, hi, T;
    __host__ __device__ void init(int M, int N, int K, int G_, int vc) { nN = N / BM; ppu = K / (2 * BK); G = G_; T = (M / BM) * nN * ppu; lo = vc * T / G; hi = (vc + 1) * T / G; }
    __host__ __device__ bool next(int i, Unit& u) const {
        const int un = lo / ppu + i; const int s = un * ppu > lo ? un * ppu : lo, e = (un + 1) * ppu < hi ? (un + 1) * ppu : hi;
        if (s >= e) return false;
        u.pm = un / nN; u.pn = un % nN; u.k0 = 2 * (s - un * ppu); u.nk = 2 * (e - s); u.which = (s > un * ppu) ? 1 : 0; return true;
    }
    __device__ __forceinline__ void a_ready(const Unit&) const {}
    __device__ __forceinline__ void done(const Unit&) const {}
};

struct HybridOrder {
    static constexpr bool SPLITK = true;
    StaticOrder so; int c, ppu, nsl;
    __host__ __device__ void init(int K, int G_, int c_) { so.init(64 * BM, 1024, G_, c_); c = c_; ppu = K / (2 * BK); nsl = ppu < 16 ? ppu : 16; }
    __host__ __device__ bool next(int i, Unit& u) const {
        if (i == 0) { const bool ok = so.next(0, u); u.k0 = 0; u.nk = 2 * ppu; u.which = -1; return ok; }
        if (i == 1) { const int lu = c >> 4, s = c & 15; if (s >= nsl || lu >= 16) return false; const int q = ppu / nsl, r = ppu % nsl; const int start = s < r ? s * (q + 1) : r * (q + 1) + (s - r) * q, len = s < r ? q + 1 : q;
            u.pm = 64 + (lu >> 2); u.pn = lu & 3; u.k0 = 2 * start; u.nk = 2 * len; u.which = s; return true; }
        return false;
    }
    __device__ __forceinline__ void a_ready(const Unit&) const {}
    __device__ __forceinline__ void done(const Unit&) const {}
};

typedef float f32x2_t __attribute__((ext_vector_type(2))); typedef __bf16 bf16x2_t __attribute__((ext_vector_type(2)));
__device__ __forceinline__ unsigned cvt_pk_bf16(float lo, float hi) { unsigned r; asm volatile("v_cvt_pk_bf16_f32 %0, %1, %2" : "=v"(r) : "v"(lo), "v"(hi)); return r; }
__device__ __forceinline__ unsigned cvt_pk_s(float lo, float hi) { f32x2_t v = {lo, hi}; bf16x2_t b = __builtin_convertvector(v, bf16x2_t); return __builtin_bit_cast(unsigned, b); }
typedef unsigned u32x2 __attribute__((ext_vector_type(2)));
__device__ __forceinline__ float sigmoidf_fast(float x) { return __builtin_amdgcn_rcpf(1.0f + __builtin_amdgcn_exp2f(-1.44269504f * x)); }
struct EpiPlain {
    static constexpr bool PERM = true, AFTER_DRAIN = false;
    bf16_t* O; int ldc; float one; size_t off1;
    __device__ __forceinline__ void operator()(const f32x4 (&acc)[2][2][4][2], const Unit& u, int wr, int wc, int fr, int fq) const {
        const int row0 = u.pm * BM + wr * 64 + fr; const int col0 = u.pn * BM + wc * 32 + 8 * fq;
#pragma unroll
        for (int ai = 0; ai < 2; ++ai)
#pragma unroll
            for (int m = 0; m < 4; ++m) { bf16_t* rowp = (u.which < 0 ? O : O + off1 + (size_t)u.which * (1024 * 1024) - (size_t)(64 * BM) * 1024) + (size_t)(row0 + ai * HALF + m * 16) * ldc + col0;
#pragma unroll
                for (int bj = 0; bj < 2; ++bj) { const f32x4 v0 = acc[ai][bj][m][0] * one, v1 = acc[ai][bj][m][1] * one;
                    u32x4 w; w.x = cvt_pk_bf16(v0[0], v0[1]); w.y = cvt_pk_bf16(v0[2], v0[3]); w.z = cvt_pk_bf16(v1[0], v1[1]); w.w = cvt_pk_bf16(v1[2], v1[3]);
                    *(u32x4*)(rowp + bj * HALF) = w; } }
    }
};
struct EpiSwiGLU {
    static constexpr bool PERM = true, AFTER_DRAIN = false;
    bf16_t* O; int ldc;
    __device__ __forceinline__ void operator()(const f32x4 (&acc)[2][2][4][2], const Unit& u, int wr, int wc, int fr, int fq) const {
        const int row0 = u.pm * BM + wr * 64 + fr; const int col0 = u.pn * HALF + wc * 32 + 8 * fq;
#pragma unroll
        for (int ai = 0; ai < 2; ++ai)
#pragma unroll
            for (int m = 0; m < 4; ++m) { bf16_t* rowp = O + (size_t)(row0 + ai * HALF + m * 16) * ldc + col0;
                float r[8];
#pragma unroll
                for (int n = 0; n < 2; ++n)
#pragma unroll
                    for (int e = 0; e < 4; ++e) { const float g = acc[ai][0][m][n][e], up = acc[ai][1][m][n][e]; r[n * 4 + e] = g * sigmoidf_fast(g) * up; }
                u32x4 w; w.x = cvt_pk_bf16(r[0], r[1]); w.y = cvt_pk_bf16(r[2], r[3]); w.z = cvt_pk_bf16(r[4], r[5]); w.w = cvt_pk_bf16(r[6], r[7]);
                *(u32x4*)rowp = w; }
    }
};
struct EpiZ {
    static constexpr bool PERM = true, AFTER_DRAIN = false;
    bf16_t* O; int ldc; float one;
    __device__ __forceinline__ void operator()(const f32x4 (&acc)[2][2][4][2], const Unit& u, int wr, int wc, int fr, int fq) const {
        const int row0 = u.pm * BM + wr * 64 + fr;
        if (u.pn == 3 || u.pn == 4) {
            const int col0 = 768 + (u.pn - 3) * HALF + wc * 32 + 8 * fq;
#pragma unroll
            for (int ai = 0; ai < 2; ++ai)
#pragma unroll
                for (int m = 0; m < 4; ++m) { bf16_t* rowp = O + (size_t)(row0 + ai * HALF + m * 16) * ldc + col0;
                    float r[8];
#pragma unroll
                    for (int n = 0; n < 2; ++n)
#pragma unroll
                        for (int e = 0; e < 4; ++e) { const float ga = acc[ai][0][m][n][e], gb = acc[ai][1][m][n][e]; r[n * 4 + e] = ga * sigmoidf_fast(gb); }
                    u32x4 w; w.x = cvt_pk_bf16(r[0], r[1]); w.y = cvt_pk_bf16(r[2], r[3]); w.z = cvt_pk_bf16(r[4], r[5]); w.w = cvt_pk_bf16(r[6], r[7]);
                    *(u32x4*)rowp = w; }
        } else {
            const int col0 = (u.pn == 5 ? 1024 : u.pn * BM) + wc * 32 + 8 * fq;
#pragma unroll
            for (int ai = 0; ai < 2; ++ai)
#pragma unroll
                for (int m = 0; m < 4; ++m) { bf16_t* rowp = O + (size_t)(row0 + ai * HALF + m * 16) * ldc + col0;
#pragma unroll
                    for (int bj = 0; bj < 2; ++bj) { const f32x4 v0 = acc[ai][bj][m][0] * one, v1 = acc[ai][bj][m][1] * one;
                        u32x4 w; w.x = cvt_pk_bf16(v0[0], v0[1]); w.y = cvt_pk_bf16(v0[2], v0[3]); w.z = cvt_pk_bf16(v1[0], v1[1]); w.w = cvt_pk_bf16(v1[2], v1[3]);
                        *(u32x4*)(rowp + bj * HALF) = w; } }
        }
    }
};

template <class Epi, class Sched, bool ALIGN_EPI = false, bool SP2 = false>
__device__ __forceinline__ void gemm_phase(PG8_LAS unsigned char* lds, const Gemm g, const Sched& S, const Epi& E) {
    int tid_ = threadIdx.x; asm volatile("" : "+v"(tid_)); const int tid = tid_, wid = __builtin_amdgcn_readfirstlane(tid >> 6), lane = tid & 63, wr = wid >> 2, wc = wid & 3, fr = lane & 15, fq = lane >> 4;
    const int K = g.K, nt_full = K / BK;
    unsigned voffA[2], voffB[2];
#pragma unroll
    for (int i = 0; i < 2; ++i) { int R, C; stage_rc(tid * 16 + i * 8192, R, C); const int Rb = Epi::PERM ? ((R & ~31) + perm32(R & 31)) : R;
        voffA[i] = (unsigned)(R * K + C) * 2u; voffB[i] = (unsigned)(Rb * K + C) * 2u; }
    const size_t kstep = (size_t)(BK * 2);
    const size_t hstep = (size_t)HALF * K * 2;
    const size_t tstep = 2 * hstep;
    const unsigned ldsw = (unsigned)wid * 1024u;
    const int aoff = lds_byte(wr * 64 + fr, fq * 8), boff = lds_byte(wc * 32 + fr, fq * 8);
#define PG8_SA(b, h) (((b) * 2 + (h)) * HTB)
#define PG8_SB(b, h) ((4 + (b) * 2 + (h)) * HTB)
#define PG8_STAGE(bufoff, gbase, voff) do { _Pragma("unroll") for (int _i = 0; _i < 2; ++_i) \
        __builtin_amdgcn_global_load_lds((const unsigned*)((const char*)(gbase) + (voff)[_i]), (PG8_LAS unsigned*)(lds + (bufoff) + ldsw + _i * 8192), 16, 0, 0); } while (0)
#define PG8_LDA(dst, b, h) do { _Pragma("unroll") for (int m = 0; m < 4; ++m) _Pragma("unroll") for (int k = 0; k < 2; ++k) dst[m][k] = *(const PG8_LAS bf16x8*)(lds + PG8_SA(b, h) + aoff + m * 2048 + k * 1024); } while (0)
#define PG8_LDB(dst, b, h) do { _Pragma("unroll") for (int n = 0; n < 2; ++n) _Pragma("unroll") for (int k = 0; k < 2; ++k) dst[n][k] = *(const PG8_LAS bf16x8*)(lds + PG8_SB(b, h) + boff + n * 2048 + k * 1024); } while (0)
#define PG8_MMA(ai, bj, At, Bt) do { __builtin_amdgcn_s_setprio(1); _Pragma("unroll") for (int m = 0; m < 4; ++m) _Pragma("unroll") for (int n = 0; n < 2; ++n) _Pragma("unroll") for (int k = 0; k < 2; ++k) \
        acc[ai][bj][m][n] = __builtin_amdgcn_mfma_f32_16x16x32_bf16(Bt[n][k], At[m][k], acc[ai][bj][m][n], 0, 0, 0); __builtin_amdgcn_s_setprio(0); } while (0)
#define PG8_WAIT_V(n) asm volatile("s_waitcnt vmcnt(" #n ")" ::: "memory")
#define PG8_WAIT_L(n) asm volatile("s_waitcnt lgkmcnt(" #n ")" ::: "memory")
#define PG8_BAR __builtin_amdgcn_s_barrier()
#define PG8_SCHED __builtin_amdgcn_sched_barrier(0)
    Unit cur, nxt; int ui = 0;
    if (!S.next(0, cur)) return;
    f32x4 acc[2][2][4][2];
#pragma unroll
    for (int a = 0; a < 2; ++a)
#pragma unroll
        for (int b = 0; b < 2; ++b)
#pragma unroll
            for (int m = 0; m < 4; ++m)
#pragma unroll
                for (int n = 0; n < 2; ++n) acc[a][b][m][n] = (f32x4){0.f, 0.f, 0.f, 0.f};
    bf16x8 At[4][2], B0[2][2], B1[2][2];
    if (!Sched::SPLITK) { cur.k0 = 0; cur.nk = nt_full; cur.which = 0; }
    const char* cA = (const char*)g.A + (size_t)cur.pm * tstep + (size_t)cur.k0 * (BK * 2); const char* cB = (const char*)g.Bt + (size_t)cur.pn * tstep + (size_t)cur.k0 * (BK * 2);
    S.a_ready(cur);
    if constexpr (SP2) {
        PG8_STAGE(PG8_SB(0, 0), cB, voffB); PG8_STAGE(PG8_SB(0, 1), cB + hstep, voffB); PG8_STAGE(PG8_SA(0, 0), cA, voffA); PG8_STAGE(PG8_SA(0, 1), cA + hstep, voffA);
        if (wr == 1) PG8_BAR;
        PG8_WAIT_V(2); PG8_BAR;
        PG8_STAGE(PG8_SB(1, 0), cB + kstep, voffB); PG8_STAGE(PG8_SA(1, 0), cA + kstep, voffA); PG8_STAGE(PG8_SB(1, 1), cB + hstep + kstep, voffB);
        PG8_WAIT_V(6); PG8_BAR;
    } else {
        PG8_STAGE(PG8_SB(0, 0), cB, voffB); PG8_STAGE(PG8_SA(0, 0), cA, voffA); PG8_STAGE(PG8_SB(0, 1), cB + hstep, voffB); PG8_STAGE(PG8_SA(0, 1), cA + hstep, voffA);
        if (wr == 1) PG8_BAR;
        PG8_WAIT_V(4); PG8_BAR;
        PG8_STAGE(PG8_SB(1, 0), cB + kstep, voffB); PG8_STAGE(PG8_SA(1, 0), cA + kstep, voffA); PG8_STAGE(PG8_SB(1, 1), cB + hstep + kstep, voffB);
        PG8_WAIT_V(6); PG8_BAR;
    }
    for (;;) {
        const bool has_next = S.next(ui + 1, nxt);
        if (!Sched::SPLITK) { nxt.k0 = 0; nxt.nk = nt_full; nxt.which = 0; }
        const char* nA = has_next ? (const char*)g.A + (size_t)nxt.pm * tstep + (size_t)nxt.k0 * (BK * 2) : cA; const char* nB = has_next ? (const char*)g.Bt + (size_t)nxt.pn * tstep + (size_t)nxt.k0 * (BK * 2) : cB;
        const int nt = cur.nk;
        for (int t = 0; t < nt; t += 2) {
            const bool last = (t == nt - 2);
            const char* a1 = cA + (size_t)(t + 1) * kstep;
            const char* a2 = last ? nA : cA + (size_t)(t + 2) * kstep; const char* b2 = last ? nB : cB + (size_t)(t + 2) * kstep;
            const char* a3 = a2 + kstep; const char* b3 = b2 + kstep;
            if (last && has_next) S.a_ready(nxt);
            if constexpr (SP2) {
            PG8_LDB(B0, 0, 0); PG8_LDB(B1, 0, 1); PG8_SCHED; PG8_LDA(At, 0, 0); PG8_STAGE(PG8_SA(1, 1), a1 + hstep, voffA);
            PG8_WAIT_V(8); PG8_WAIT_L(0); PG8_BAR; PG8_MMA(0, 0, At, B0); PG8_MMA(0, 1, At, B1); PG8_BAR; PG8_SCHED;
            PG8_LDA(At, 0, 1); PG8_STAGE(PG8_SB(0, 0), b2, voffB); PG8_STAGE(PG8_SB(0, 1), b2 + hstep, voffB); PG8_STAGE(PG8_SA(0, 0), a2, voffA);
            PG8_WAIT_V(8); PG8_WAIT_L(0); PG8_BAR; PG8_MMA(1, 0, At, B0); PG8_MMA(1, 1, At, B1); PG8_BAR; PG8_SCHED;
            PG8_LDB(B0, 1, 0); PG8_LDB(B1, 1, 1); PG8_SCHED; PG8_LDA(At, 1, 0); PG8_STAGE(PG8_SA(0, 1), a2 + hstep, voffA);
            PG8_WAIT_V(8); PG8_WAIT_L(0); PG8_BAR; PG8_MMA(0, 0, At, B0); PG8_MMA(0, 1, At, B1); PG8_BAR; PG8_SCHED;
            PG8_LDA(At, 1, 1); PG8_STAGE(PG8_SB(1, 0), b3, voffB); PG8_STAGE(PG8_SB(1, 1), b3 + hstep, voffB); PG8_STAGE(PG8_SA(1, 0), a3, voffA);
            PG8_WAIT_V(8); PG8_WAIT_L(0); PG8_BAR; PG8_MMA(1, 0, At, B0); PG8_MMA(1, 1, At, B1); PG8_BAR; PG8_SCHED;
            } else {
            PG8_LDB(B0, 0, 0); PG8_SCHED; PG8_LDA(At, 0, 0); PG8_STAGE(PG8_SA(1, 1), a1 + hstep, voffA);
            PG8_WAIT_L(8); PG8_BAR; PG8_WAIT_L(0); PG8_MMA(0, 0, At, B0); PG8_BAR; PG8_SCHED;
            PG8_LDB(B1, 0, 1); PG8_STAGE(PG8_SB(0, 0), b2, voffB);
            PG8_BAR; PG8_WAIT_L(0); PG8_MMA(0, 1, At, B1); PG8_BAR;
            PG8_LDA(At, 0, 1); PG8_STAGE(PG8_SA(0, 0), a2, voffA);
            PG8_BAR; PG8_WAIT_L(0); PG8_MMA(1, 0, At, B0); PG8_BAR; PG8_SCHED;
            PG8_STAGE(PG8_SB(0, 1), b2 + hstep, voffB);
            PG8_WAIT_V(6); PG8_BAR; PG8_MMA(1, 1, At, B1); PG8_BAR;
            PG8_LDB(B0, 1, 0); PG8_SCHED; PG8_LDA(At, 1, 0); PG8_STAGE(PG8_SA(0, 1), a2 + hstep, voffA);
            PG8_WAIT_L(8); PG8_BAR; PG8_WAIT_L(0); PG8_MMA(0, 0, At, B0); PG8_BAR; PG8_SCHED;
            PG8_LDB(B1, 1, 1); PG8_STAGE(PG8_SB(1, 0), b3, voffB);
            PG8_BAR; PG8_WAIT_L(0); PG8_MMA(0, 1, At, B1); PG8_BAR;
            PG8_LDA(At, 1, 1); PG8_STAGE(PG8_SA(1, 0), a3, voffA);
            PG8_BAR; PG8_WAIT_L(0); PG8_MMA(1, 0, At, B0); PG8_BAR; PG8_SCHED;
            PG8_STAGE(PG8_SB(1, 1), b3 + hstep, voffB);
            PG8_WAIT_V(6); PG8_BAR; PG8_MMA(1, 1, At, B1); PG8_BAR;
            }
        }
        if constexpr (ALIGN_EPI) { if (wr == 0) PG8_BAR; }
        if constexpr (!Epi::AFTER_DRAIN) { E(acc, cur, wr, wc, fr, fq); S.done(cur); }
        if (!has_next) break;
#pragma unroll
        for (int a = 0; a < 2; ++a)
#pragma unroll
            for (int b = 0; b < 2; ++b)
#pragma unroll
                for (int m = 0; m < 4; ++m)
#pragma unroll
                    for (int n = 0; n < 2; ++n) acc[a][b][m][n] = (f32x4){0.f, 0.f, 0.f, 0.f};
        cur = nxt; cA = nA; cB = nB; ++ui;
        if constexpr (ALIGN_EPI) { if (wr == 1) PG8_BAR; }
    }
    PG8_WAIT_V(0);
    if constexpr (!ALIGN_EPI) { if (wr == 0) PG8_BAR; }
    PG8_BAR;
    if constexpr (Epi::AFTER_DRAIN) { E.fused(acc, cur, wr, wc, fr, fq, lds, wid, lane); S.done(cur); }
#undef PG8_SA
#undef PG8_SB
#undef PG8_STAGE
#undef PG8_LDA
#undef PG8_LDB
#undef PG8_MMA
#undef PG8_WAIT_V
#undef PG8_WAIT_L
#undef PG8_BAR
#undef PG8_SCHED
}
}
constexpr int DM = 1024, MP = 16384, MS = 1024, MTOK = MP + MS, DFF = 2816, NGU = 2 * DFF, NIN = 1536, ZLD = 1280, DEPTH = 4;
constexpr int SEQ = 2048, DSEQ = 8, NB = 8, NDB = 128;
constexpr float RMS_EPS = 1e-6f, LN_EPS = 1e-5f;
constexpr size_t O_Y = 0, O_KP = 17825792, O_VP = 18350080, O_CP = 18874368, O_PP = 19120128, O_KS = 19243008, O_VS = 27631616, O_CS = 36020224, O_PS = 39952384, O_END = 41918464;
constexpr size_t MiB = 1u << 20;
constexpr size_t WS_WPAD = 128 * 1024;
constexpr size_t WS_W = 1 * MiB, W_LAYER = 38 * MiB;
constexpr size_t W_GU1 = 0, W_D1 = 11 * MiB, W_IN = 16 * MiB + MiB / 2, W_OUT = 19 * MiB + MiB / 2, W_GU2 = 21 * MiB + MiB / 2, W_D2 = 32 * MiB + MiB / 2;
constexpr size_t WS_U = WS_W + 4 * W_LAYER;
constexpr size_t WS_ACT = WS_U + 34 * MiB;
constexpr size_t WS_Z = WS_ACT, WS_MIX = WS_ACT + 48 * MiB;
constexpr size_t WS_D1 = WS_ACT + 94 * MiB;
constexpr size_t WS_HB = WS_D1 + 34 * MiB;
constexpr size_t WS_END = WS_HB + 34 * MiB;
static_assert((size_t)MTOK * DM * 2 <= 34 * MiB && (size_t)MTOK * DFF * 2 <= 94 * MiB && (size_t)MTOK * ZLD * 2 <= 48 * MiB && 48 * MiB + (size_t)MTOK * DM * 2 <= 94 * MiB, "ws map");
constexpr int LDS_BYTES = 147456;
#ifndef MK_DUP
#define MK_DUP 0
#endif
#define REP(bit) for (int rep_ = 0; rep_ < ((MK_DUP & (bit)) ? 2 : 1); ++rep_)
constexpr int NPH_FULL = 1 + 10 * DEPTH;
#ifndef MK_PH_HI
#define MK_PH_HI NPH_FULL
#endif
constexpr int NPH = MK_PH_HI;

#define LAS __attribute__((address_space(3)))
typedef unsigned short bf16;
typedef float f32x4 __attribute__((ext_vector_type(4)));
typedef short bf16x8 __attribute__((ext_vector_type(8)));
typedef unsigned u32x4 __attribute__((ext_vector_type(4)));
typedef unsigned u32x2 __attribute__((ext_vector_type(2)));
#define LDS_WAIT() asm volatile("s_waitcnt lgkmcnt(0)" ::: "memory")
using pg8::cvt_pk_bf16;
__device__ __forceinline__ void st_bf4_mfma(unsigned short* p, float __attribute__((ext_vector_type(4))) v) { unsigned __attribute__((ext_vector_type(2))) w; w.x = pg8::cvt_pk_s(v.x, v.y); w.y = pg8::cvt_pk_s(v.z, v.w); *(unsigned __attribute__((ext_vector_type(2)))*)p = w; }
__device__ __forceinline__ float bf2f(unsigned short b) { return __uint_as_float((unsigned)b << 16); }
__device__ __forceinline__ f32x4 ld_bf4(const bf16* p) { const u32x2 v = *(const u32x2*)p; f32x4 r; r.x = __uint_as_float(v.x << 16); r.y = __uint_as_float(v.x & 0xffff0000u); r.z = __uint_as_float(v.y << 16); r.w = __uint_as_float(v.y & 0xffff0000u); return r; }
__device__ __forceinline__ void st_bf4(bf16* p, f32x4 v) { u32x2 w; w.x = cvt_pk_bf16(v.x, v.y); w.y = cvt_pk_bf16(v.z, v.w); *(u32x2*)p = w; }
__device__ __forceinline__ float dpp_xadd(float v, int ctrl) { return v; }
template <int CTRL> __device__ __forceinline__ float dpp_add(float v) { return v + __builtin_bit_cast(float, __builtin_amdgcn_update_dpp(0, __builtin_bit_cast(int, v), CTRL, 0xf, 0xf, false)); }
__device__ __forceinline__ float wave_sum(float v) {
    v = dpp_add<0xB1>(v); v = dpp_add<0x4E>(v); v = dpp_add<0x141>(v); v = dpp_add<0x140>(v);
    const int b = __builtin_bit_cast(int, v);
    return (__builtin_bit_cast(float, __builtin_amdgcn_readlane(b, 0)) + __builtin_bit_cast(float, __builtin_amdgcn_readlane(b, 16))) + (__builtin_bit_cast(float, __builtin_amdgcn_readlane(b, 32)) + __builtin_bit_cast(float, __builtin_amdgcn_readlane(b, 48)));
}

struct Params { const float* in[23]; float* out; unsigned char* ws; int ph_lo, ph_hi; float one; int pad; };
enum { I_XP = 0, I_XS, I_SK, I_SV, I_SC, I_SP, I_NG, I_F1G, I_F1U, I_F1D, I_WIN, I_SINK, I_DWW, I_DWB, I_LNG, I_LNB, I_PW, I_POOLW, I_PSC, I_WOUT, I_F2G, I_F2U, I_F2D };

__device__ __forceinline__ void transpose_item(const float* __restrict__ W, int N, int k0, int n0, bf16* dst, int ldk, LAS float* scr, int lane) {
    float v[32];
#pragma unroll
    for (int i = 0; i < 32; ++i) { const int kk = 2 * i + (lane >> 5); v[i] = __builtin_nontemporal_load(W + (size_t)(k0 + kk) * N + n0 + (lane & 31)); }
#pragma unroll
    for (int i = 0; i < 32; ++i) { const int kk = 2 * i + (lane >> 5); scr[kk * 33 + (lane & 31)] = v[i]; }
    LDS_WAIT();
    const int c = lane & 7;
#pragma unroll
    for (int j = 0; j < 4; ++j) { const int n = (lane >> 3) + 8 * j; const LAS float* s = scr + (8 * c) * 33 + n;
        u32x4 o; o.x = cvt_pk_bf16(s[0 * 33], s[1 * 33]); o.y = cvt_pk_bf16(s[2 * 33], s[3 * 33]); o.z = cvt_pk_bf16(s[4 * 33], s[5 * 33]); o.w = cvt_pk_bf16(s[6 * 33], s[7 * 33]);
        *(u32x4*)(dst + (size_t)n * ldk + k0 + 8 * c) = o; }
    LDS_WAIT();
}
__device__ __forceinline__ int rowmap_gu(int n, int up) { return (n >> 7) * 256 + up * 128 + (n & 127); }
__device__ __forceinline__ int rowmap_in(int n) {
    if (n < 768 || n >= 1280) return n;
    if (n < 1024) { const int ch = n - 768; return 768 + (ch >> 7) * 256 + (ch & 127); }
    const int ch = n - 1024; return 768 + (ch >> 7) * 256 + 128 + (ch & 127);
}
template <bool HAS_D>
__device__ __forceinline__ void norm_row(const float* R, bf16* UD, float* H, const float* ga, float c, const float* gb, int lane, const bf16* P = nullptr, int nsl = 0) {
    f32x4 h[4];
#pragma unroll
    for (int j = 0; j < 4; ++j) h[j] = *(const f32x4*)(R + j * 256 + lane * 4);
    if (HAS_D) {
        f32x4 d[4]; float ss = 0.f;
#pragma unroll
        for (int j = 0; j < 4; ++j) { if (nsl == 0) d[j] = ld_bf4(UD + j * 256 + lane * 4); else { d[j] = ld_bf4(P + j * 256 + lane * 4); for (int s = 1; s < nsl; ++s) d[j] = d[j] + ld_bf4(P + (size_t)s * (1024 * 1024) + j * 256 + lane * 4); } ss += (d[j].x * d[j].x + d[j].y * d[j].y) + (d[j].z * d[j].z + d[j].w * d[j].w); }
        const float rstd = __builtin_amdgcn_rsqf(wave_sum(ss) * (1.f / DM) + RMS_EPS) * c;
#pragma unroll
        for (int j = 0; j < 4; ++j) { const f32x4 g = *(const f32x4*)(ga + j * 256 + lane * 4); h[j] = h[j] + d[j] * g * rstd; *(f32x4*)(H + j * 256 + lane * 4) = h[j]; }
    }
    if (gb) {
        float ss = 0.f;
#pragma unroll
        for (int j = 0; j < 4; ++j) ss += (h[j].x * h[j].x + h[j].y * h[j].y) + (h[j].z * h[j].z + h[j].w * h[j].w);
        const float rstd = __builtin_amdgcn_rsqf(wave_sum(ss) * (1.f / DM) + RMS_EPS);
#pragma unroll
        for (int j = 0; j < 4; ++j) { const f32x4 g = *(const f32x4*)(gb + j * 256 + lane * 4); st_bf4(UD + j * 256 + lane * 4, h[j] * g * rstd); }
    }
}

template <bool RBF> __device__ __forceinline__ f32x4 ld_res(const void* base, size_t off) { if (RBF) return ld_bf4((const bf16*)base + off); else return *(const f32x4*)((const float*)base + off); }
template <bool WF32> __device__ __forceinline__ void st_res(void* base, size_t off, f32x4 v) { if (WF32) *(f32x4*)((float*)base + off) = v; else st_bf4((bf16*)base + off, v); }
template <int NSL, bool RBF, bool WF32>
__device__ __forceinline__ void norm_phase(const void* Rp, const void* Rs, bf16* U, void* Hout, const bf16* P, const float* ga, float c, const float* gb, int gw, int ngw, int lane) {
    f32x4 gA[4], gB[4];
#pragma unroll
    for (int j = 0; j < 4; ++j) { gA[j] = *(const f32x4*)(ga + j * 256 + lane * 4) * c; gB[j] = gb ? *(const f32x4*)(gb + j * 256 + lane * 4) : (f32x4){0.f, 0.f, 0.f, 0.f}; }
    constexpr int RB = 2;
#pragma unroll 1
    for (int row0 = gw; row0 < MP; row0 += RB * ngw) {
        f32x4 h[RB][4], d[RB][4];
#pragma unroll
        for (int q = 0; q < RB; ++q) { const int row = row0 + q * ngw; if (row < MP) {
#pragma unroll
            for (int j = 0; j < 4; ++j) { h[q][j] = ld_res<RBF>(Rp, (size_t)row * DM + j * 256 + lane * 4); d[q][j] = ld_bf4(U + (size_t)row * DM + j * 256 + lane * 4); } } }
#pragma unroll
        for (int q = 0; q < RB; ++q) { const int row = row0 + q * ngw; if (row < MP) {
            float ss = 0.f;
#pragma unroll
            for (int j = 0; j < 4; ++j) ss += (d[q][j].x * d[q][j].x + d[q][j].y * d[q][j].y) + (d[q][j].z * d[q][j].z + d[q][j].w * d[q][j].w);
            const float rstd = __builtin_amdgcn_rsqf(wave_sum(ss) * (1.f / DM) + RMS_EPS);
            float s2 = 0.f;
#pragma unroll
            for (int j = 0; j < 4; ++j) { h[q][j] = h[q][j] + d[q][j] * gA[j] * rstd; st_res<WF32>(Hout, (size_t)row * DM + j * 256 + lane * 4, h[q][j]);
                s2 += (h[q][j].x * h[q][j].x + h[q][j].y * h[q][j].y) + (h[q][j].z * h[q][j].z + h[q][j].w * h[q][j].w); }
            if (gb) { const float r2 = __builtin_amdgcn_rsqf(wave_sum(s2) * (1.f / DM) + RMS_EPS);
#pragma unroll
                for (int j = 0; j < 4; ++j) st_bf4(U + (size_t)row * DM + j * 256 + lane * 4, h[q][j] * gB[j] * r2); } } }
    }
#pragma unroll 1
    for (int row = MP + gw; row < MTOK; row += ngw) {
        f32x4 h[4], d[4];
#pragma unroll
        for (int j = 0; j < 4; ++j) { h[j] = ld_res<RBF>(Rs, (size_t)(row - MP) * DM + j * 256 + lane * 4); d[j] = (f32x4){0.f, 0.f, 0.f, 0.f}; }
#pragma unroll
        for (int s = 0; s < NSL; ++s)
#pragma unroll
            for (int j = 0; j < 4; ++j) d[j] = d[j] + ld_bf4(P + (size_t)s * (1024 * 1024) + (size_t)(row - MP) * DM + j * 256 + lane * 4);
        float ss = 0.f;
#pragma unroll
        for (int j = 0; j < 4; ++j) ss += (d[j].x * d[j].x + d[j].y * d[j].y) + (d[j].z * d[j].z + d[j].w * d[j].w);
        const float rstd = __builtin_amdgcn_rsqf(wave_sum(ss) * (1.f / DM) + RMS_EPS);
        float s2 = 0.f;
#pragma unroll
        for (int j = 0; j < 4; ++j) { h[j] = h[j] + d[j] * gA[j] * rstd; st_res<WF32>(Hout, (size_t)row * DM + j * 256 + lane * 4, h[j]); s2 += (h[j].x * h[j].x + h[j].y * h[j].y) + (h[j].z * h[j].z + h[j].w * h[j].w); }
        if (gb) { const float r2 = __builtin_amdgcn_rsqf(wave_sum(s2) * (1.f / DM) + RMS_EPS);
#pragma unroll
            for (int j = 0; j < 4; ++j) st_bf4(U + (size_t)row * DM + j * 256 + lane * 4, h[j] * gB[j] * r2); }
    }
}
__device__ __forceinline__ unsigned hb_mask(int row, int ppu, int G) { const int T = (MTOK / 256) * 4 * ppu; unsigned m = 0u;
#pragma unroll
    for (int j = 0; j < 4; ++j) { const int un = (row >> 8) * 4 + j; const int c0 = ((un * ppu + 1) * G - 1) / T, c1 = (((un + 1) * ppu) * G - 1) / T; m |= (c0 != c1 ? 1u : 0u) << j; }
    return m; }
__device__ __forceinline__ const float* xrow(const Params& p, int row) { return row < MP ? p.in[I_XP] + (size_t)row * DM : p.in[I_XS] + (size_t)(row - MP) * DM; }


__device__ __forceinline__ void state_shift_copy(const Params& p, int l, int tix, int nthr) {
    constexpr int PER = 3840 + 3840 + 1408 + 448;
    for (int idx = tix; idx < NDB * PER; idx += nthr) { const int lb = l * NDB + idx / PER; int r = idx % PER; const float* src; float* dst;
        if (r < 3840) { src = p.in[I_SK] + (size_t)lb * 16384 + 1024 + r * 4; dst = p.out + O_KS + (size_t)lb * 16384 + r * 4; }
        else if (r < 7680) { r -= 3840; src = p.in[I_SV] + (size_t)lb * 16384 + 1024 + r * 4; dst = p.out + O_VS + (size_t)lb * 16384 + r * 4; }
        else if (r < 9088) { r -= 7680; src = p.in[I_SC] + (size_t)lb * 7680 + 2048 + r * 4; dst = p.out + O_CS + (size_t)lb * 7680 + r * 4; }
        else { r -= 9088; src = p.in[I_SP] + (size_t)lb * 3840 + 2048 + r * 4; dst = p.out + O_PS + (size_t)lb * 3840 + r * 4; }
        *(f32x4*)dst = *(const f32x4*)src; }
}

__device__ __forceinline__ void convert_ffn2(const Params& p, LAS unsigned char* lds, int l, int part, int wix, int nw, int wave, int lane) {
    LAS float* scr = (LAS float*)(lds + wave * 16384);
    unsigned char* wl = p.ws + WS_W + (size_t)l * W_LAYER;
    if (part == 0) {
        const float* W = p.in[I_F2D] + (size_t)l * DM * DFF;
        for (int r = wix; r < 44 * 32; r += nw) { const int kb = r / 32, nb = r % 32; transpose_item(W, DM, kb * 64, nb * 32, (bf16*)(wl + W_D2) + (size_t)(nb * 32) * DFF, DFF, scr, lane); }
    } else {
        for (int r0 = wix; r0 < 2 * 16 * 88; r0 += nw) { const int kind = r0 / (16 * 88), r = r0 % (16 * 88), kb = r / 88, nb = r % 88;
            const float* W = p.in[I_F2G + kind] + (size_t)l * DM * DFF;
            transpose_item(W, DFF, kb * 64, nb * 32, (bf16*)(wl + W_GU2) + (size_t)rowmap_gu(nb * 32, kind) * DM, DM, scr, lane); }
    }
}

__device__ __forceinline__ void prologue(const Params& p, LAS unsigned char* lds, int gw, int ngw, int wave, int lane) {
    LAS float* scr = (LAS float*)(lds + wave * 16384);
    constexpr int I_FF = 16 * 88, I_WIN_N = 16 * 48, I_WO = 8 * 32, NFF = 3, PER_L = NFF * I_FF + I_WIN_N + I_WO;
    for (int it = gw; it < DEPTH * PER_L; it += ngw) {
        const int l = it / PER_L; int r = it % PER_L;
        bf16* wl = (bf16*)(p.ws + WS_W + (size_t)l * W_LAYER);
        if (r < NFF * I_FF) {
            const int which = r / I_FF; r -= which * I_FF;
            const int half = which / 3, kind = which % 3;
            if (kind < 2) { const float* W = p.in[(half ? I_F2G : I_F1G) + kind] + (size_t)l * DM * DFF; const int kb = r / 88, nb = r % 88;
                bf16* dst = (bf16*)((unsigned char*)wl + (half ? W_GU2 : W_GU1)) + (size_t)rowmap_gu(nb * 32, kind) * DM;
                transpose_item(W, DFF, kb * 64, nb * 32, dst, DM, scr, lane); }
            else { const float* W = p.in[half ? I_F2D : I_F1D] + (size_t)l * DM * DFF; const int kb = r / 32, nb = r % 32;
                bf16* dst = (bf16*)((unsigned char*)wl + (half ? W_D2 : W_D1)) + (size_t)(nb * 32) * DFF;
                transpose_item(W, DM, kb * 64, nb * 32, dst, DFF, scr, lane); }
        } else if (r < NFF * I_FF + I_WIN_N) { r -= NFF * I_FF; const float* W = p.in[I_WIN] + (size_t)l * DM * NIN; const int kb = r / 48, nb = r % 48;
            bf16* dst = (bf16*)((unsigned char*)wl + W_IN) + (size_t)rowmap_in(nb * 32) * DM;
            transpose_item(W, NIN, kb * 64, nb * 32, dst, DM, scr, lane);
        } else { r -= NFF * I_FF + I_WIN_N; const float* W = p.in[I_WOUT] + (size_t)l * DM * DM; const int kb = r / 32, nb = r % 32;
            bf16* dst = (bf16*)((unsigned char*)wl + W_OUT) + (size_t)(nb * 32) * DM;
            transpose_item(W, DM, kb * 64, nb * 32, dst, DM, scr, lane); }
    }
    for (int fi0 = gw; fi0 < DEPTH * 1024; fi0 += ngw) {
        const int fi = (fi0 >= 2048) ? (fi0 ^ 512) : fi0;
        const int l = fi >> 10, kb = (fi & 1023) >> 4, n = (fi & 15) * 64 + lane;
        const float* wo = p.in[I_WOUT] + (size_t)l * DM * DM;
        float acc[8];
#pragma unroll
        for (int i = 0; i < 8; ++i) acc[i] = 0.f;
        if (kb < 32) {
            const float* pw = p.in[I_PW] + (size_t)l * 65536 + (size_t)(kb * 8) * 256; const float* wc = wo + (size_t)512 * DM + n;
#pragma unroll 1
            for (int j0 = 0; j0 < 256; j0 += 16) { float wv[16];
#pragma unroll
                for (int jj = 0; jj < 16; ++jj) wv[jj] = wc[(size_t)(j0 + jj) * DM];
#pragma unroll
                for (int jj = 0; jj < 16; ++jj)
#pragma unroll
                    for (int i = 0; i < 8; ++i) acc[i] += pw[i * 256 + j0 + jj] * wv[jj]; }
        } else {
            const int kk = (kb - 32) * 8, gi = kk >> 6, c0 = kk & 63;
            const float* pl = p.in[I_POOLW] + (size_t)l * 16384 + gi * 4096 + c0 * 64; const float* sc = p.in[I_PSC] + l * 256 + gi * 64; const float* wc = wo + (size_t)(768 + gi * 64) * DM + n;
#pragma unroll 1
            for (int d0 = 0; d0 < 64; d0 += 16) { float wv[16];
#pragma unroll
                for (int jj = 0; jj < 16; ++jj) wv[jj] = wc[(size_t)(d0 + jj) * DM] * sc[d0 + jj];
#pragma unroll
                for (int jj = 0; jj < 16; ++jj)
#pragma unroll
                    for (int i = 0; i < 8; ++i) acc[i] += pl[i * 64 + d0 + jj] * wv[jj]; }
        }
        u32x4 o; o.x = cvt_pk_bf16(acc[0], acc[1]); o.y = cvt_pk_bf16(acc[2], acc[3]); o.z = cvt_pk_bf16(acc[4], acc[5]); o.w = cvt_pk_bf16(acc[6], acc[7]);
        *(u32x4*)((bf16*)(p.ws + WS_W + (size_t)l * W_LAYER + W_OUT) + (size_t)n * DM + 512 + kb * 8) = o;
    }
    { float* wp = (float*)(p.ws + WS_WPAD); for (int idx = gw * 64 + lane; idx < DEPTH * 64 * 256; idx += ngw * 64) { const int l = idx >> 14, j = ((idx >> 8) & 63) - 15, c = idx & 255; wp[idx] = (j >= 0 && j <= 30) ? p.in[I_DWW][(size_t)l * 31 * 256 + j * 256 + c] : 0.f; } }
    bf16* U = (bf16*)(p.ws + WS_U);
    {
        f32x4 g0[4];
#pragma unroll
        for (int j = 0; j < 4; ++j) g0[j] = *(const f32x4*)(p.in[I_NG] + j * 256 + lane * 4);
#pragma unroll 1
        for (int row0 = gw; row0 < MTOK; row0 += 2 * ngw) {
            f32x4 h[2][4];
#pragma unroll
            for (int q = 0; q < 2; ++q) { const int row = row0 + q * ngw; if (row < MTOK) { const float* R = xrow(p, row);
#pragma unroll
                for (int j = 0; j < 4; ++j) h[q][j] = *(const f32x4*)(R + j * 256 + lane * 4); } }
#pragma unroll
            for (int q = 0; q < 2; ++q) { const int row = row0 + q * ngw; if (row < MTOK) { float ss = 0.f;
#pragma unroll
                for (int j = 0; j < 4; ++j) ss += (h[q][j].x * h[q][j].x + h[q][j].y * h[q][j].y) + (h[q][j].z * h[q][j].z + h[q][j].w * h[q][j].w);
                const float rstd = __builtin_amdgcn_rsqf(wave_sum(ss) * (1.f / DM) + RMS_EPS);
#pragma unroll
                for (int j = 0; j < 4; ++j) st_bf4(U + (size_t)row * DM + j * 256 + lane * 4, h[q][j] * g0[j] * rstd); } }
        }
    }
}

constexpr int KSTR = 72, VSTR = 264, KTILE = 256 * KSTR, VTILE = 64 * VSTR, VT_OFF = 2 * KTILE * 2;
static_assert(VT_OFF + 2 * VTILE * 2 <= LDS_BYTES, "attention LDS");
template <int NKB>
__device__ __forceinline__ void attn_wave(const LAS bf16* Ks, const LAS bf16* Vt, const bf16x8 qf0, const bf16x8 qf1, int qi, int j0, int lim, float slope, float sink, bf16* optr, int fr, int fq) {
    constexpr float LOG2E = 1.44269504f;
    bf16x8 qf[2]; qf[0] = qf0; qf[1] = qf1;
    f32x4 s[NKB];
#pragma unroll
    for (int kb = 0; kb < NKB; ++kb) { s[kb] = (f32x4){0.f, 0.f, 0.f, 0.f};
#pragma unroll
        for (int kc = 0; kc < 2; ++kc) { const bf16x8 a = *(const LAS bf16x8*)(Ks + (kb * 16 + fr) * KSTR + kc * 32 + fq * 8); s[kb] = __builtin_amdgcn_mfma_f32_16x16x32_bf16(a, qf[kc], s[kb], 0, 0, 0); } }
    const int base = qi + 128 - j0 - 4 * fq; const float slope2 = slope * LOG2E, b0 = -slope2 * (float)base, sink2 = sink * LOG2E;
    float mx = -1e30f;
#pragma unroll
    for (int kb = 0; kb < NKB; ++kb)
#pragma unroll
        for (int i = 0; i < 4; ++i) { const int c = kb * 16 + i; const bool valid = (unsigned)(base - c) < (unsigned)lim;
            const float lg = valid ? __builtin_fmaf(s[kb][i], 0.125f * LOG2E, __builtin_fmaf(slope2, (float)c, b0)) : -1e30f; s[kb][i] = lg; mx = fmaxf(mx, lg); }
    mx = fmaxf(mx, __shfl_xor(mx, 16)); mx = fmaxf(mx, __shfl_xor(mx, 32)); mx = fmaxf(mx, sink2);
    float sum = 0.f;
#pragma unroll
    for (int kb = 0; kb < NKB; ++kb)
#pragma unroll
        for (int i = 0; i < 4; ++i) { const float e = __builtin_amdgcn_exp2f(s[kb][i] - mx); s[kb][i] = e; sum += e; }
    sum += __shfl_xor(sum, 16); sum += __shfl_xor(sum, 32);
    const float inv = 1.0f / (sum + __builtin_amdgcn_exp2f(sink2 - mx));
    bf16x8 pf[NKB / 2];
#pragma unroll
    for (int kc = 0; kc < NKB / 2; ++kc) { u32x4 w; w.x = cvt_pk_bf16(s[2 * kc][0] * inv, s[2 * kc][1] * inv); w.y = cvt_pk_bf16(s[2 * kc][2] * inv, s[2 * kc][3] * inv);
        w.z = cvt_pk_bf16(s[2 * kc + 1][0] * inv, s[2 * kc + 1][1] * inv); w.w = cvt_pk_bf16(s[2 * kc + 1][2] * inv, s[2 * kc + 1][3] * inv); pf[kc] = __builtin_bit_cast(bf16x8, w); }
#pragma unroll
    for (int db = 0; db < 4; ++db) { f32x4 o = (f32x4){0.f, 0.f, 0.f, 0.f};
#pragma unroll
        for (int kc = 0; kc < NKB / 2; ++kc) { const LAS bf16* vp = Vt + (db * 16 + fr) * VSTR + kc * 32 + 4 * fq;
            const u32x2 lo = *(const LAS u32x2*)vp, hi = *(const LAS u32x2*)(vp + 16); u32x4 a; a.x = lo.x; a.y = lo.y; a.z = hi.x; a.w = hi.y;
            o = __builtin_amdgcn_mfma_f32_16x16x32_bf16(__builtin_bit_cast(bf16x8, a), pf[kc], o, 0, 0, 0); }
        st_bf4_mfma(optr + db * 16 + 4 * fq, o); }
}


template <bool SAMP, int NT>
__device__ __forceinline__ void convpool_unit(const Params& p, const bf16* Z, bf16* MIX, int l, int row0, int b, int t0, int lane_in) {
    int lane = lane_in; asm volatile("" : "+v"(lane));
    const int ch = lane * 4;
    const f32x4 zero4 = (f32x4){0.f, 0.f, 0.f, 0.f};
    {
        const float* dw = (const float*)(p.ws + WS_WPAD) + (size_t)l * 64 * 256 + 15 * 256 + ch;
        const float* sc = p.in[I_SC] + (size_t)(l * NDB + b) * 30 * 256 + ch;
        const bf16* zg = Z + (size_t)(SAMP ? MP + b * DSEQ : b * SEQ) * ZLD + 768 + ch;
        constexpr int NROW = 30 + NT, NRB = (NROW + 7) / 8 * 8;
        f32x4 acc[NT];
#pragma unroll
        for (int tt = 0; tt < NT; ++tt) acc[tt] = zero4;
        u32x2 nv[8];
        if (!SAMP) {
#pragma unroll
            for (int i = 0; i < 8; ++i) { const int t = t0 + i - 30, tc = t < 0 ? 0 : t; nv[i] = *(const u32x2*)(zg + (size_t)tc * ZLD); } }
#pragma unroll 1
        for (int r0 = 0; r0 < NRB; r0 += 8) {
            f32x4 val[8];
#pragma unroll
            for (int i = 0; i < 8; ++i) { const int r = r0 + i;
                if (SAMP) { const int rs = r < 29 ? r : 29, rz = r < 30 ? 0 : (r > 37 ? 7 : r - 30); const f32x4 a = *(const f32x4*)(sc + rs * 256), z = ld_bf4(zg + (size_t)rz * ZLD); val[i] = r < 30 ? a : z; }
                else { const int t = t0 + r - 30; f32x4 z; z.x = __uint_as_float(nv[i].x << 16); z.y = __uint_as_float(nv[i].x & 0xffff0000u); z.z = __uint_as_float(nv[i].y << 16); z.w = __uint_as_float(nv[i].y & 0xffff0000u); val[i] = t >= 0 ? z : zero4; } }
            if (!SAMP) {
#pragma unroll
                for (int i = 0; i < 8; ++i) { const int t = t0 + r0 + 8 + i - 30, tc = t < 0 ? 0 : (t > SEQ - 1 ? SEQ - 1 : t); nv[i] = *(const u32x2*)(zg + (size_t)tc * ZLD); } }
#pragma unroll
            for (int hh = 0; hh < NT / 8; ++hh) {
                f32x4 wb[15];
#pragma unroll
                for (int k = 0; k < 15; ++k) wb[k] = *(const f32x4*)(dw + (r0 - 8 * hh - 7 + k) * 256);
#pragma unroll
                for (int i = 0; i < 8; ++i)
#pragma unroll
                    for (int tt = 0; tt < 8; ++tt) acc[8 * hh + tt] += wb[i - tt + 7] * val[i];
            }
#pragma unroll
            for (int i = 0; i < 8; ++i) { const int r = r0 + i; if (r >= 30 && r < NROW) { const int tok = r - 30;
                if (SAMP) *(f32x4*)(p.out + O_CS + ((size_t)(l * NDB + b) * 30 + 22 + tok) * 256 + ch) = val[i];
                else if (t0 + tok >= SEQ - 30) *(f32x4*)(p.out + O_CP + ((size_t)(l * NB + b) * 30 + (t0 + tok - (SEQ - 30))) * 256 + ch) = val[i]; } }
        }
        const f32x4 bias = *(const f32x4*)(p.in[I_DWB] + l * 256 + ch), lg = *(const f32x4*)(p.in[I_LNG] + l * 256 + ch), lb = *(const f32x4*)(p.in[I_LNB] + l * 256 + ch);
#pragma unroll
        for (int tt = 0; tt < NT; ++tt) { const f32x4 c = acc[tt] + bias; const float mean = wave_sum((c.x + c.y) + (c.z + c.w)) * (1.f / 256.f); const f32x4 d = c - mean;
            const float var = wave_sum((d.x * d.x + d.y * d.y) + (d.z * d.z + d.w * d.w)) * (1.f / 256.f); const float rstd = __builtin_amdgcn_rsqf(var + LN_EPS);
            f32x4 y = d * rstd * lg + lb; y.x *= pg8::sigmoidf_fast(y.x); y.y *= pg8::sigmoidf_fast(y.y); y.z *= pg8::sigmoidf_fast(y.z); y.w *= pg8::sigmoidf_fast(y.w);
            st_bf4(MIX + (size_t)(row0 + tt) * DM + 512 + ch, y); }
    }
    {
        const int wsz = 2 << (lane >> 4);
        const float f4 = wsz >= 4 ? 1.f : 0.f, f8 = wsz >= 8 ? 1.f : 0.f, f16 = wsz >= 16 ? 1.f : 0.f;
        const float* sp = p.in[I_SP] + (size_t)(l * NDB + b) * 15 * 256 + ch;
        const bf16* zp = Z + (size_t)(SAMP ? MP + b * DSEQ : b * SEQ) * ZLD + 1024 + ch;
        constexpr int NROW = 15 + NT, NRB = (NROW + 7) / 8 * 8;
        f32x4 acc[NT];
#pragma unroll
        for (int tt = 0; tt < NT; ++tt) acc[tt] = zero4;
#pragma unroll
        for (int r0 = 0; r0 < NRB; r0 += 8) {
            f32x4 val[8];
#pragma unroll
            for (int i = 0; i < 8; ++i) { const int r = r0 + i;
                if (SAMP) { const int rs = r < 14 ? r : 14, rz = r < 15 ? 0 : (r > 22 ? 7 : r - 15); if (r < 15) val[i] = *(const f32x4*)(sp + rs * 256); else val[i] = ld_bf4(zp + (size_t)rz * ZLD); }
                else { const int t = t0 + r - 15, tc = t < 0 ? 0 : (t > SEQ - 1 ? SEQ - 1 : t); const f32x4 z = ld_bf4(zp + (size_t)tc * ZLD); val[i] = t >= 0 ? z : zero4; } }
#pragma unroll
            for (int i = 0; i < 8; ++i)
#pragma unroll
                for (int tt = 0; tt < NT; ++tt) { const int ii = 15 + tt - (r0 + i);
                    if (ii == 0) { const int pos = SAMP ? 8192 + tt : t0 + tt; const int cnt = wsz < pos + 1 ? wsz : pos + 1; acc[tt] += val[i] * (1.f - (float)cnt); }
                    else if (ii == 1) acc[tt] += val[i];
                    else if (ii >= 2 && ii < 4) acc[tt] += val[i] * f4;
                    else if (ii >= 4 && ii < 8) acc[tt] += val[i] * f8;
                    else if (ii >= 8 && ii < 16) acc[tt] += val[i] * f16; }
#pragma unroll
            for (int i = 0; i < 8; ++i) { const int r = r0 + i; if (r >= 15 && r < NROW) { const int tok = r - 15;
                if (SAMP) *(f32x4*)(p.out + O_PS + ((size_t)(l * NDB + b) * 15 + 7 + tok) * 256 + ch) = val[i];
                else if (t0 + tok >= SEQ - 15) *(f32x4*)(p.out + O_PP + ((size_t)(l * NB + b) * 15 + (t0 + tok - (SEQ - 15))) * 256 + ch) = val[i]; } }
            asm volatile("" ::: "memory");
        }
#pragma unroll
        for (int tt = 0; tt < NT; ++tt) { const int pos = SAMP ? 8192 + tt : t0 + tt; const int cnt = wsz < pos + 1 ? wsz : pos + 1; const float ic = 1.0f / (float)cnt;
            st_bf4(MIX + (size_t)(row0 + tt) * DM + 768 + ch, acc[tt] * ic); }
    }
}

__device__ __forceinline__ void mixer_phase(const Params& p, LAS unsigned char* lds, int l, int gw, int ngw, int wave, int lane, int tid) {
    const bf16* Z = (const bf16*)(p.ws + WS_Z); bf16* MIX = (bf16*)(p.ws + WS_MIX);
    LAS bf16* Ks = (LAS bf16*)lds; LAS bf16* Vt = (LAS bf16*)(lds + VT_OFF);
    const int fr = lane & 15, fq = lane >> 4;
    const float* sinks = p.in[I_SINK] + l * 8;
    for (int uid = blockIdx.x; uid < 256 + NDB; uid += gridDim.x) {
        __syncthreads();
        if (uid < 256) {
            const int b = uid >> 5, qb = (uid >> 1) & 15, kv = uid & 1;
            u32x4 k4s[4], v4s[4];
#pragma unroll
            for (int it = 0; it < 4; ++it) { const int c = tid + it * 512, j = c >> 3, dc = (c & 7) * 8, t = qb * 128 - 128 + j;
                k4s[it] = (u32x4){0u, 0u, 0u, 0u}; v4s[it] = k4s[it];
                if (t >= 0) { const bf16* zr = Z + (size_t)(b * SEQ + t) * ZLD; k4s[it] = *(const u32x4*)(zr + 512 + kv * 64 + dc); v4s[it] = *(const u32x4*)(zr + 640 + kv * 64 + dc); } }
#pragma unroll
            for (int it = 0; it < 4; ++it) { const int c = tid + it * 512, j = c >> 3, dc = (c & 7) * 8; const u32x4 k4 = k4s[it], v4 = v4s[it];
                *(LAS u32x4*)(Ks + j * KSTR + dc) = k4;
                const unsigned vv[4] = {v4.x, v4.y, v4.z, v4.w};
#pragma unroll
                for (int e = 0; e < 4; ++e) { Vt[(dc + 2 * e) * VSTR + j] = (bf16)(vv[e] & 0xffffu); Vt[(dc + 2 * e + 1) * VSTR + j] = (bf16)(vv[e] >> 16); }
                if (qb == 15 && j >= 128) { const size_t o = ((size_t)(l * NB + b) * 128 + (j - 128)) * 128 + kv * 64 + dc; float* ko = p.out + O_KP + o; float* vo = p.out + O_VP + o;
                    const unsigned kk[4] = {k4.x, k4.y, k4.z, k4.w};
                    *(f32x4*)ko = (f32x4){__uint_as_float(kk[0] << 16), __uint_as_float(kk[0] & 0xffff0000u), __uint_as_float(kk[1] << 16), __uint_as_float(kk[1] & 0xffff0000u)};
                    *(f32x4*)(ko + 4) = (f32x4){__uint_as_float(kk[2] << 16), __uint_as_float(kk[2] & 0xffff0000u), __uint_as_float(kk[3] << 16), __uint_as_float(kk[3] & 0xffff0000u)};
                    *(f32x4*)vo = (f32x4){__uint_as_float(vv[0] << 16), __uint_as_float(vv[0] & 0xffff0000u), __uint_as_float(vv[1] << 16), __uint_as_float(vv[1] & 0xffff0000u)};
                    *(f32x4*)(vo + 4) = (f32x4){__uint_as_float(vv[2] << 16), __uint_as_float(vv[2] & 0xffff0000u), __uint_as_float(vv[3] << 16), __uint_as_float(vv[3] & 0xffff0000u)}; }
            }
            __syncthreads();
            const int g = wave >> 1, h = kv * 4 + g; const float slope = __builtin_amdgcn_exp2f(-(float)(h + 1)), sink = sinks[h];
            const bf16* qp0 = Z + ((size_t)b * SEQ + qb * 128 + (wave & 1) * 64 + fr) * ZLD + h * 64 + fq * 8;
            bf16x8 q0 = *(const bf16x8*)qp0, q1 = *(const bf16x8*)(qp0 + 32);
#pragma unroll 1
            for (int qq = 0; qq < 4; ++qq) { const int qi = (wave & 1) * 64 + qq * 16 + fr; const size_t row = (size_t)b * SEQ + qb * 128 + qi;
                const bf16* qn = qp0 + (size_t)((qq + 1) & 3) * 16 * ZLD; const bf16x8 n0 = *(const bf16x8*)qn, n1 = *(const bf16x8*)(qn + 32);
                const int j0 = (((wave & 1) * 4 + qq) & ~1) * 16;
                attn_wave<10>(Ks + j0 * KSTR, Vt + j0, q0, q1, qi, j0, qb == 0 ? qi + 1 : 128, slope, sink, MIX + row * DM + h * 64, fr, fq); q0 = n0; q1 = n1; }
        } else {
            const int b = uid - 256;
            for (int c = tid; c < 160 * 16; c += 512) { const int j = c >> 4, kvh = (c >> 3) & 1, dc = (c & 7) * 8;
                u32x4 k4 = (u32x4){0u, 0u, 0u, 0u}, v4 = k4;
                if (j < 128) { const size_t o = ((size_t)(l * NDB + b) * 128 + j) * 128 + kvh * 64 + dc; const float* ks = p.in[I_SK] + o; const float* vs = p.in[I_SV] + o;
                    const f32x4 a0 = *(const f32x4*)ks, a1 = *(const f32x4*)(ks + 4), b0 = *(const f32x4*)vs, b1 = *(const f32x4*)(vs + 4);
                    k4.x = cvt_pk_bf16(a0.x, a0.y); k4.y = cvt_pk_bf16(a0.z, a0.w); k4.z = cvt_pk_bf16(a1.x, a1.y); k4.w = cvt_pk_bf16(a1.z, a1.w);
                    v4.x = cvt_pk_bf16(b0.x, b0.y); v4.y = cvt_pk_bf16(b0.z, b0.w); v4.z = cvt_pk_bf16(b1.x, b1.y); v4.w = cvt_pk_bf16(b1.z, b1.w); }
                else if (j < 136) { const bf16* zr = Z + (size_t)(MP + b * DSEQ + (j - 128)) * ZLD; k4 = *(const u32x4*)(zr + 512 + kvh * 64 + dc); v4 = *(const u32x4*)(zr + 640 + kvh * 64 + dc);
                    const size_t o = ((size_t)(l * NDB + b) * 128 + 120 + (j - 128)) * 128 + kvh * 64 + dc; float* ko = p.out + O_KS + o; float* vo = p.out + O_VS + o;
                    const unsigned kk[4] = {k4.x, k4.y, k4.z, k4.w}, vv2[4] = {v4.x, v4.y, v4.z, v4.w};
                    *(f32x4*)ko = (f32x4){__uint_as_float(kk[0] << 16), __uint_as_float(kk[0] & 0xffff0000u), __uint_as_float(kk[1] << 16), __uint_as_float(kk[1] & 0xffff0000u)};
                    *(f32x4*)(ko + 4) = (f32x4){__uint_as_float(kk[2] << 16), __uint_as_float(kk[2] & 0xffff0000u), __uint_as_float(kk[3] << 16), __uint_as_float(kk[3] & 0xffff0000u)};
                    *(f32x4*)vo = (f32x4){__uint_as_float(vv2[0] << 16), __uint_as_float(vv2[0] & 0xffff0000u), __uint_as_float(vv2[1] << 16), __uint_as_float(vv2[1] & 0xffff0000u)};
                    *(f32x4*)(vo + 4) = (f32x4){__uint_as_float(vv2[2] << 16), __uint_as_float(vv2[2] & 0xffff0000u), __uint_as_float(vv2[3] << 16), __uint_as_float(vv2[3] & 0xffff0000u)}; }
                *(LAS u32x4*)(Ks + kvh * KTILE + j * KSTR + dc) = k4;
                const unsigned vv[4] = {v4.x, v4.y, v4.z, v4.w};
#pragma unroll
                for (int e = 0; e < 4; ++e) { Vt[kvh * VTILE + (dc + 2 * e) * VSTR + j] = (bf16)(vv[e] & 0xffffu); Vt[kvh * VTILE + (dc + 2 * e + 1) * VSTR + j] = (bf16)(vv[e] >> 16); }
            }
            __syncthreads();
            if (wave < 4) { const int kvh = wave >> 1, rr = (wave & 1) * 16 + fr, qi = rr & 7, h = kvh * 4 + (rr >> 3);
                const float slope = __builtin_amdgcn_exp2f(-(float)(h + 1)), sink = sinks[h]; const size_t row = (size_t)MP + b * DSEQ + qi;
                const bf16* qp = Z + row * ZLD + h * 64;
                attn_wave<10>(Ks + kvh * KTILE, Vt + kvh * VTILE, *(const bf16x8*)(qp + fq * 8), *(const bf16x8*)(qp + 32 + fq * 8), qi, 0, 128, slope, sink, MIX + row * DM + h * 64, fr, fq); }
        }
    }
    if (ngw == 2048) {
        if (blockIdx.x >= 128) { const int unit = ((int)blockIdx.x - 128) * 8 + wave; convpool_unit<false, 16>(p, Z, MIX, l, unit * 16, unit >> 7, (unit & 127) * 16, lane); }
        else if (wave == 4) { const int sb = (int)blockIdx.x; convpool_unit<true, 8>(p, Z, MIX, l, MP + sb * 8, sb, 0, lane); }
    } else {
        for (int unit = gw; unit < MP / 16 + NDB; unit += ngw) {
            if (unit < MP / 16) convpool_unit<false, 16>(p, Z, MIX, l, unit * 16, unit >> 7, (unit & 127) * 16, lane);
            else convpool_unit<true, 8>(p, Z, MIX, l, MP + (unit - MP / 16) * 8, unit - MP / 16, 0, lane);
        }
    }
}

#define XB_TMO      128
#define XB_XCNT(j)  (256  + 64 * (j))
#define XB_XSUB(j)  (1280 + 64 * (j))
#define XB_XGEN(j)  (2304 + 64 * (j))
#define XB_TOP      3328
#define XB_TOPGEN   3392
#define XCD_BAR_WORDS 3456
#define XB_SPIN_CAP (1u << 18)
__device__ __forceinline__ unsigned xb_ld(unsigned* p)              { return __hip_atomic_load(p, __ATOMIC_RELAXED, __HIP_MEMORY_SCOPE_AGENT); }
__device__ __forceinline__ unsigned xb_add(unsigned* p, unsigned v) { return __hip_atomic_fetch_add(p, v, __ATOMIC_RELAXED, __HIP_MEMORY_SCOPE_AGENT); }
__device__ __forceinline__ unsigned xb_xcc_id() { return (unsigned)__builtin_amdgcn_s_getreg((3 << 11) | 20) & 0xFu; }
#define XB_SPIN(cond, bar) do { unsigned _sp = 0; while (cond) { __builtin_amdgcn_s_sleep(1); \
    if ((++_sp & 255u) == 0u) { if (xb_ld(&(bar)[XB_TMO])) break; if (_sp > XB_SPIN_CAP) { atomicAdd(&(bar)[XB_TMO], 1u); break; } } } } while (0)
struct XcdBarrier { unsigned* bar; unsigned x; volatile LAS unsigned* st; };
__device__ __forceinline__ XcdBarrier xcd_barrier_post(unsigned* bar, volatile LAS unsigned* st) {
    XcdBarrier b; b.bar = bar; b.x = xb_xcc_id(); b.st = st;
    if (threadIdx.x == 0) (void)xb_add(&bar[XB_XCNT(b.x)], 1u);
    return b;
}
__device__ __forceinline__ void xcd_barrier_complete(unsigned* bar, unsigned x, unsigned& nloc, unsigned& nx) {
    const unsigned G = gridDim.x * gridDim.y * gridDim.z;
    unsigned sum, cnt, mine, sp = 0u;
    for (;;) {
        sum = 0u; cnt = 0u; mine = 0u;
#pragma unroll
        for (unsigned j = 0; j < 16; ++j) { const unsigned c = xb_ld(&bar[XB_XCNT(j)]); sum += c; cnt += (c > 0u) ? 1u : 0u; mine = (j == x) ? c : mine; }
        if (sum == G) break;
        __builtin_amdgcn_s_sleep(1);
        if ((++sp & 255u) == 0u) { if (xb_ld(&bar[XB_TMO])) break; if (sp > XB_SPIN_CAP) { atomicAdd(&bar[XB_TMO], 1u); break; } }
    }
    nloc = mine > 0u ? mine : 1u; nx = cnt > 0u ? cnt : 1u;
}
__device__ __forceinline__ void xcd_barrier(const XcdBarrier& b) {
    asm volatile("s_waitcnt vmcnt(0)" ::: "memory");
    __syncthreads();
    if (threadIdx.x == 0) {
        unsigned* bar = b.bar;
        __builtin_amdgcn_s_waitcnt(0);
        unsigned nloc = b.st[0], nx = b.st[1];
        if (nloc == 0u) { xcd_barrier_complete(bar, b.x, nloc, nx); b.st[0] = nloc; b.st[1] = nx; }
        const unsigned old = xb_add(&bar[XB_XSUB(b.x)], 1u);
        const unsigned gen = old / nloc;
        if (old + 1u == (gen + 1u) * nloc) {
            __builtin_amdgcn_fence(__ATOMIC_RELEASE, "agent");
            asm volatile("s_waitcnt vmcnt(0)" ::: "memory");
            const unsigned og = xb_add(&bar[XB_TOP], 1u);
            const unsigned tg = og / nx;
            if (og + 1u == (tg + 1u) * nx) xb_add(&bar[XB_TOPGEN], 1u);
            else XB_SPIN(xb_ld(&bar[XB_TOPGEN]) == tg, bar);
            __builtin_amdgcn_fence(__ATOMIC_ACQUIRE, "agent");
            xb_add(&bar[XB_XGEN(b.x)], 1u);
            asm volatile("s_waitcnt vmcnt(0)" ::: "memory");
        } else {
            XB_SPIN(xb_ld(&bar[XB_XGEN(b.x)]) == gen, bar);
            __builtin_amdgcn_fence(__ATOMIC_ACQUIRE, "agent");
            asm volatile("s_waitcnt vmcnt(0)" ::: "memory");
        }
    }
    __syncthreads();
}

__global__ void __launch_bounds__(512, 2) mega_fwd(Params p) {
    extern __shared__ __attribute__((aligned(16))) unsigned char lds_raw[];
    LAS unsigned char* lds = (LAS unsigned char*)lds_raw;
    cg::grid_group grid = cg::this_grid();
    const int lo = p.ph_lo, hi = p.ph_hi;
    const int ngw = gridDim.x * 8;
    unsigned* barw = (unsigned*)p.ws;
    volatile LAS unsigned* bst = (volatile LAS unsigned*)(lds + LDS_BYTES - 16);
    if (threadIdx.x == 0) { bst[0] = 0u; bst[1] = 0u; }
    __syncthreads();
    XcdBarrier xbar = xcd_barrier_post(barw, bst);
    if (hi == -12345) grid.sync();
    const float one = p.one;
#define FRESH() int tid_ = threadIdx.x; asm volatile("" : "+v"(tid_)); const int lane = tid_ & 63, wave = __builtin_amdgcn_readfirstlane(tid_ >> 6), gw = blockIdx.x * 8 + wave
#define IN(k) (lo <= (k) && (k) < hi)
#define SEAM(k) do { if (lo <= (k) && (k) + 1 < hi) { xcd_barrier(xbar); if (MK_DUP & 64) xcd_barrier(xbar); } } while (0)
    bf16* U = (bf16*)(p.ws + WS_U); bf16* ACT = (bf16*)(p.ws + WS_ACT); bf16* Zb = (bf16*)(p.ws + WS_Z); bf16* MIX = (bf16*)(p.ws + WS_MIX);
    float* H = p.out; const bf16* D1b = (const bf16*)(p.ws + WS_D1); bf16* Hb = (bf16*)(p.ws + WS_HB);
    const int vcu = (gridDim.x % 8 == 0) ? (int)(blockIdx.x % 8) * (int)(gridDim.x / 8) + (int)(blockIdx.x / 8) : (int)blockIdx.x;
    if (IN(0)) REP(1) { FRESH(); prologue(p, lds, gw, ngw, wave, lane); }
    SEAM(0);
#pragma unroll 1
    for (int l = 0; l < DEPTH; ++l) {
        const int pb = 1 + 10 * l;
        const unsigned char* wl = p.ws + WS_W + (size_t)l * W_LAYER;
        const float* ng = p.in[I_NG] + (size_t)l * 6 * DM;
#pragma unroll 1
        for (int half = 0; half < 2; ++half) {
            const int hb = pb + (half ? 7 : 0);
            if (IN(hb)) REP(2) {
                pg8::Gemm g{U, (const bf16*)(wl + (half ? W_GU2 : W_GU1)), MTOK, NGU, DM}; pg8::StaticOrder S; S.init(MTOK, NGU, gridDim.x, blockIdx.x);
                pg8::EpiSwiGLU E{ACT, DFF};
                pg8::gemm_phase<pg8::EpiSwiGLU, pg8::StaticOrder, true, true>(lds, g, S, E);
                if (half == 0) { constexpr int NU1 = (MTOK / 256) * (NGU / 256); const int nfull = NU1 % (int)gridDim.x;
                    FRESH(); if (rep_ == 0) { if (nfull > 0 && (int)blockIdx.x >= nfull) convert_ffn2(p, lds, l, 0, ((int)blockIdx.x - nfull) * 8 + wave, ((int)gridDim.x - nfull) * 8, wave, lane); else if (nfull == 0) convert_ffn2(p, lds, l, 0, gw, ngw, wave, lane); } }
            }
            SEAM(hb);
            if (IN(hb + 1)) REP(4) {
                pg8::Gemm g{ACT, (const bf16*)(wl + (half ? W_D2 : W_D1)), MTOK, DM, DFF}; pg8::HybridOrder S; S.init(DFF, gridDim.x, blockIdx.x);
                pg8::EpiPlain E{U, DM, one, (WS_D1 - WS_U) / 2};
                pg8::gemm_phase<pg8::EpiPlain, pg8::HybridOrder, true, true>(lds, g, S, E);
            }
            SEAM(hb + 1);
            if (IN(hb + 2)) {
                FRESH();
                const float* ga = ng + (half ? 5 : 1) * DM; const float* gb = half ? (l + 1 < DEPTH ? ng + 6 * DM : nullptr) : ng + 2 * DM;
                if (l == 0 && half == 0) norm_phase<16, false, false>(p.in[I_XP], p.in[I_XS], U, Hb, D1b, ga, 0.5f, gb, gw, ngw, lane);
                else if (l == DEPTH - 1 && half == 1) norm_phase<16, true, true>(Hb, Hb + (size_t)MP * DM, U, H, D1b, ga, 0.5f, gb, gw, ngw, lane);
                else norm_phase<16, true, false>(Hb, Hb + (size_t)MP * DM, U, Hb, D1b, ga, 0.5f, gb, gw, ngw, lane);
            }
            SEAM(hb + 2);
            if (half == 0) {
                if (IN(pb + 3)) REP(8) {
                    pg8::Gemm g{U, (const bf16*)(wl + W_IN), MTOK, NIN, DM}; pg8::StaticOrder S; S.init(MTOK, NIN, gridDim.x, blockIdx.x);
                    pg8::EpiZ E{Zb, ZLD, one};
                    pg8::gemm_phase<pg8::EpiZ, pg8::StaticOrder, true, true>(lds, g, S, E);
                    { constexpr int NU = (MTOK / 256) * (NIN / 256); const int nfull = NU % (int)gridDim.x;
                      FRESH(); if (rep_ == 0) { if (nfull > 0 && (int)blockIdx.x >= nfull) { state_shift_copy(p, l, ((int)blockIdx.x - nfull) * 512 + tid_, ((int)gridDim.x - nfull) * 512); convert_ffn2(p, lds, l, 1, ((int)blockIdx.x - nfull) * 8 + wave, ((int)gridDim.x - nfull) * 8, wave, lane); } else if (nfull == 0) { state_shift_copy(p, l, (int)blockIdx.x * 512 + tid_, (int)gridDim.x * 512); convert_ffn2(p, lds, l, 1, gw, ngw, wave, lane); } } }
                }
                SEAM(pb + 3);
                if (IN(pb + 4)) REP(16) { FRESH(); mixer_phase(p, lds, l, gw, ngw, wave, lane, tid_); }
                SEAM(pb + 4);
                if (IN(pb + 5)) REP(32) {
                    pg8::Gemm g{MIX, (const bf16*)(wl + W_OUT), MTOK, DM, DM}; pg8::HybridOrder S; S.init(DM, gridDim.x, blockIdx.x);
                    pg8::EpiPlain E{U, DM, one, (WS_D1 - WS_U) / 2};
                    pg8::gemm_phase<pg8::EpiPlain, pg8::HybridOrder, true, true>(lds, g, S, E);
                }
                SEAM(pb + 5);
                if (IN(pb + 6)) {
                    FRESH();
                    norm_phase<8, true, false>(Hb, Hb + (size_t)MP * DM, U, Hb, D1b, ng + 3 * DM, 1.0f, ng + 4 * DM, gw, ngw, lane);
                }
                SEAM(pb + 6);
            }
        }
    }
#undef IN
#undef SEAM
#undef FRESH
}

extern "C" void kernel_launch(void* const* d_in, const int* in_sizes, int n_in, void* d_out, int out_size, void* d_ws, size_t ws_size, hipStream_t stream) {
    static int grid = 0;
    if (grid == 0) {
        if (n_in != 23 || (size_t)out_size != O_END || ws_size < WS_END) { fprintf(stderr, "kernel_launch: unexpected shapes: n_in %d out %d ws %zu\n", n_in, out_size, ws_size); grid = -1; return; }
        int dev = 0, cus = 0, per_cu = 0;
        hipGetDevice(&dev); hipDeviceGetAttribute(&cus, hipDeviceAttributeMultiprocessorCount, dev);
        if (hipFuncSetAttribute((const void*)mega_fwd, hipFuncAttributeMaxDynamicSharedMemorySize, LDS_BYTES) != hipSuccess) { fprintf(stderr, "kernel_launch: hipFuncSetAttribute failed\n"); grid = -1; return; }
        if (hipOccupancyMaxActiveBlocksPerMultiprocessor(&per_cu, (const void*)mega_fwd, 512, LDS_BYTES) != hipSuccess || per_cu < 1) { fprintf(stderr, "kernel_launch: occupancy query says %d\n", per_cu); per_cu = 1; }
        (void)hipGetLastError();
        grid = cus * 1;
        if (grid != 256) { fprintf(stderr, "kernel_launch: built for a 256-CU device (hybrid split-K order); got %d\n", grid); grid = -1; return; }
        fprintf(stderr, "kernel_launch: grid %d (cus %d, per_cu %d)\n", grid, cus, per_cu);
    }
    if (grid < 0) return;
    if (hipMemsetAsync(d_ws, 0, 16384, stream) != hipSuccess) { fprintf(stderr, "kernel_launch: memset of the barrier words failed\n"); return; }
    Params a{};
    for (int i = 0; i < 23; ++i) a.in[i] = (const float*)d_in[i];
    a.out = (float*)d_out; a.ws = (unsigned char*)d_ws; a.one = 1.0f;
#if MK_MULTI_LAUNCH
    for (int k = 0; k < NPH; ++k) { a.ph_lo = k; a.ph_hi = k + 1; hipLaunchKernelGGL(mega_fwd, dim3(grid), dim3(512), LDS_BYTES, stream, a); }
#else
    a.ph_lo = 0; a.ph_hi = NPH;
    void* args[] = {&a};
    hipError_t e = hipLaunchCooperativeKernel((const void*)mega_fwd, dim3(grid), dim3(512), args, LDS_BYTES, stream);
    if (e != hipSuccess) fprintf(stderr, "kernel_launch: cooperative launch failed: %s (grid %d)\n", hipGetErrorString(e), grid);
#endif
}
```

```cpp
#include <hip/hip_runtime.h>
#include <hip/hip_cooperative_groups.h>
#include <cstdio>
#include <cstdint>
namespace cg = cooperative_groups;
#ifndef MK_MULTI_LAUNCH
#define MK_MULTI_LAUNCH 0
#endif
namespace pg8 {
#define PG8_LAS __attribute__((address_space(3)))
typedef unsigned short bf16_t;
typedef short bf16x8 __attribute__((ext_vector_type(8)));
typedef float f32x4 __attribute__((ext_vector_type(4)));
typedef unsigned u32x4 __attribute__((ext_vector_type(4)));
constexpr int BM = 256, BK = 64, HALF = 128, HTB = HALF * BK * 2  , STAGE_BYTES = 8 * HTB, NXCD = 8, WGM = 8;

__host__ __device__ __forceinline__ int lds_byte(int r, int c) { const int st = (r >> 4) * 2 + (c >> 5), rr = r & 15, cc = c & 31, ob = rr * 64 + cc * 2; return st * 1024 + (ob ^ (((ob >> 9) & 1) << 5)); }
__host__ __device__ __forceinline__ void stage_rc(int b, int& R, int& C) { const int st = b / 1024, sb = b % 1024, swz = sb ^ (((sb >> 9) & 1) << 5); R = (st >> 1) * 16 + swz / 64; C = (st & 1) * 32 + (swz % 64) / 2; }
__host__ __device__ __forceinline__ int perm32(int rho) { const int n = rho >> 4, i = rho & 15; return 8 * (i >> 2) + 4 * n + (i & 3); }

struct Unit { int pm, pn, k0, nk, which; };
struct Gemm { const bf16_t* A; const bf16_t* Bt; int M, N, K; };

struct StaticOrder {
    static constexpr bool SPLITK = false;
    int nM, nN, nwg, G, c;
    __host__ __device__ void init(int M, int N, int G_, int c_) { nM = M / BM; nN = N / BM; nwg = nM * nN; G = G_; c = c_; }
    __host__ __device__ bool next(int i, Unit& u) const {
        const long L = (long)i * G + c; if (L >= nwg) return false;
        int wgid = (int)L; { const int q = nwg / NXCD, r = nwg % NXCD, xcd = wgid % NXCD, off = wgid / NXCD; wgid = (xcd < r ? xcd * (q + 1) : r * (q + 1) + (xcd - r) * q) + off; }
        const int nig = WGM * nN, gid = wgid / nig, fm = gid * WGM, gsz = (nM - fm) < WGM ? (nM - fm) : WGM;
        u.pm = fm + ((wgid % nig) % gsz); u.pn = (wgid % nig) / gsz; return true;
    }
    __device__ __forceinline__ void a_ready(const Unit&) const {}
    __device__ __forceinline__ void done(const Unit&) const {}
};

struct StreamKOrder {
    static constexpr bool SPLITK = true;
    int nN, ppu, G, lo, hi, T;
    __host__ __device__ void init(int M, int N, int K, int G_, int vc) { nN = N / BM; ppu = K / (2 * BK); G = G_; T = (M / BM) * nN * ppu; lo = vc * T / G; hi = (vc + 1) * T / G; }
    __host__ __device__ bool next(int i, Unit& u) const {
        const int un = lo / ppu + i; const int s = un * ppu > lo ? un * ppu : lo, e = (un + 1) * ppu < hi ? (un + 1) * ppu : hi;
        if (s >= e) return false;
        u.pm = un / nN; u.pn = un % nN; u.k0 = 2 * (s - un * ppu); u.nk = 2 * (e - s); u.which = (s > un * ppu) ? 1 : 0; return true;
    }
    __device__ __forceinline__ void a_ready(const Unit&) const {}
    __device__ __forceinline__ void done(const Unit&) const {}
};

#ifndef PG8_NSL_MAX
#define PG8_NSL_MAX 8
#endif
struct HybridOrder {
    static constexpr bool SPLITK = true;
    StaticOrder so; int c, ppu, nsl;
    __host__ __device__ void init(int K, int G_, int c_) { so.init(64 * BM, 1024, G_, c_); c = c_; ppu = K / (2 * BK); nsl = ppu < PG8_NSL_MAX ? ppu : PG8_NSL_MAX; }
    __host__ __device__ bool next(int i, Unit& u) const {
        if (i == 0) { const bool ok = so.next(0, u); u.k0 = 0; u.nk = 2 * ppu; u.which = -1; return ok; }
        if (i == 1) { const int lu = c >> 4, s = c & 15; if (s >= nsl || lu >= 16) return false; const int q = ppu / nsl, r = ppu % nsl; const int start = s < r ? s * (q + 1) : r * (q + 1) + (s - r) * q, len = s < r ? q + 1 : q;
            u.pm = 64 + (lu >> 2); u.pn = lu & 3; u.k0 = 2 * start; u.nk = 2 * len; u.which = s; return true; }
        return false;
    }
    __device__ __forceinline__ void a_ready(const Unit&) const {}
    __device__ __forceinline__ void done(const Unit&) const {}
};

typedef float f32x2_t __attribute__((ext_vector_type(2))); typedef __bf16 bf16x2_t __attribute__((ext_vector_type(2)));
__device__ __forceinline__ unsigned cvt_pk_bf16(float lo, float hi) { unsigned r; asm volatile("v_cvt_pk_bf16_f32 %0, %1, %2" : "=v"(r) : "v"(lo), "v"(hi)); return r; }
__device__ __forceinline__ unsigned cvt_pk_s(float lo, float hi) { f32x2_t v = {lo, hi}; bf16x2_t b = __builtin_convertvector(v, bf16x2_t); return __builtin_bit_cast(unsigned, b); }
typedef unsigned u32x2 __attribute__((ext_vector_type(2)));
__device__ __forceinline__ float sigmoidf_fast(float x) { return __builtin_amdgcn_rcpf(1.0f + __builtin_amdgcn_exp2f(-1.44269504f * x)); }
struct EpiPlain {
    static constexpr bool PERM = true, AFTER_DRAIN = false;
    bf16_t* O; int ldc; float one; size_t off1;
    __device__ __forceinline__ void operator()(const f32x4 (&acc)[2][2][4][2], const Unit& u, int wr, int wc, int fr, int fq) const {
        const int row0 = u.pm * BM + wr * 64 + fr; const int col0 = u.pn * BM + wc * 32 + 8 * fq;
#pragma unroll
        for (int ai = 0; ai < 2; ++ai)
#pragma unroll
            for (int m = 0; m < 4; ++m) { bf16_t* rowp = (u.which < 0 ? O : O + off1 + (size_t)u.which * (1024 * 1024) - (size_t)(64 * BM) * 1024) + (size_t)(row0 + ai * HALF + m * 16) * ldc + col0;
#pragma unroll
                for (int bj = 0; bj < 2; ++bj) { const f32x4 v0 = acc[ai][bj][m][0] * one, v1 = acc[ai][bj][m][1] * one;
                    u32x4 w; w.x = cvt_pk_bf16(v0[0], v0[1]); w.y = cvt_pk_bf16(v0[2], v0[3]); w.z = cvt_pk_bf16(v1[0], v1[1]); w.w = cvt_pk_bf16(v1[2], v1[3]);
                    *(u32x4*)(rowp + bj * HALF) = w; } }
    }
};
struct EpiSwiGLU {
    static constexpr bool PERM = true, AFTER_DRAIN = false;
    bf16_t* O; int ldc;
    __device__ __forceinline__ void operator()(const f32x4 (&acc)[2][2][4][2], const Unit& u, int wr, int wc, int fr, int fq) const {
        const int row0 = u.pm * BM + wr * 64 + fr; const int col0 = u.pn * HALF + wc * 32 + 8 * fq;
#pragma unroll
        for (int ai = 0; ai < 2; ++ai)
#pragma unroll
            for (int m = 0; m < 4; ++m) { bf16_t* rowp = O + (size_t)(row0 + ai * HALF + m * 16) * ldc + col0;
                float r[8];
#pragma unroll
                for (int n = 0; n < 2; ++n)
#pragma unroll
                    for (int e = 0; e < 4; ++e) { const float g = acc[ai][0][m][n][e], up = acc[ai][1][m][n][e]; r[n * 4 + e] = g * sigmoidf_fast(g) * up; }
                u32x4 w; w.x = cvt_pk_bf16(r[0], r[1]); w.y = cvt_pk_bf16(r[2], r[3]); w.z = cvt_pk_bf16(r[4], r[5]); w.w = cvt_pk_bf16(r[6], r[7]);
                *(u32x4*)rowp = w; }
    }
};
struct EpiZ {
    static constexpr bool PERM = true, AFTER_DRAIN = false;
    bf16_t* O; int ldc; float one;
    __device__ __forceinline__ void operator()(const f32x4 (&acc)[2][2][4][2], const Unit& u, int wr, int wc, int fr, int fq) const {
        const int row0 = u.pm * BM + wr * 64 + fr;
        if (u.pn == 3 || u.pn == 4) {
            const int col0 = 768 + (u.pn - 3) * HALF + wc * 32 + 8 * fq;
#pragma unroll
            for (int ai = 0; ai < 2; ++ai)
#pragma unroll
                for (int m = 0; m < 4; ++m) { bf16_t* rowp = O + (size_t)(row0 + ai * HALF + m * 16) * ldc + col0;
                    float r[8];
#pragma unroll
                    for (int n = 0; n < 2; ++n)
#pragma unroll
                        for (int e = 0; e < 4; ++e) { const float ga = acc[ai][0][m][n][e], gb = acc[ai][1][m][n][e]; r[n * 4 + e] = ga * sigmoidf_fast(gb); }
                    u32x4 w; w.x = cvt_pk_bf16(r[0], r[1]); w.y = cvt_pk_bf16(r[2], r[3]); w.z = cvt_pk_bf16(r[4], r[5]); w.w = cvt_pk_bf16(r[6], r[7]);
                    *(u32x4*)rowp = w; }
        } else {
            const int col0 = (u.pn == 5 ? 1024 : u.pn * BM) + wc * 32 + 8 * fq;
#pragma unroll
            for (int ai = 0; ai < 2; ++ai)
#pragma unroll
                for (int m = 0; m < 4; ++m) { bf16_t* rowp = O + (size_t)(row0 + ai * HALF + m * 16) * ldc + col0;
#pragma unroll
                    for (int bj = 0; bj < 2; ++bj) { const f32x4 v0 = acc[ai][bj][m][0] * one, v1 = acc[ai][bj][m][1] * one;
                        u32x4 w; w.x = cvt_pk_bf16(v0[0], v0[1]); w.y = cvt_pk_bf16(v0[2], v0[3]); w.z = cvt_pk_bf16(v1[0], v1[1]); w.w = cvt_pk_bf16(v1[2], v1[3]);
                        *(u32x4*)(rowp + bj * HALF) = w; } }
        }
    }
};

template <class Epi, class Sched, bool ALIGN_EPI = false, bool SP2 = false>
__device__ __forceinline__ void gemm_phase(PG8_LAS unsigned char* lds, const Gemm g, const Sched& S, const Epi& E) {
    int tid_ = threadIdx.x; asm volatile("" : "+v"(tid_)); const int tid = tid_, wid = __builtin_amdgcn_readfirstlane(tid >> 6), lane = tid & 63, wr = wid >> 2, wc = wid & 3, fr = lane & 15, fq = lane >> 4;
    const int K = g.K, nt_full = K / BK;
    unsigned voffA[2], voffB[2];
#pragma unroll
    for (int i = 0; i < 2; ++i) { int R, C; stage_rc(tid * 16 + i * 8192, R, C); const int Rb = Epi::PERM ? ((R & ~31) + perm32(R & 31)) : R;
        voffA[i] = (unsigned)(R * K + C) * 2u; voffB[i] = (unsigned)(Rb * K + C) * 2u; }
    const size_t kstep = (size_t)(BK * 2);
    const size_t hstep = (size_t)HALF * K * 2;
    const size_t tstep = 2 * hstep;
    const unsigned ldsw = (unsigned)wid * 1024u;
    const int aoff = lds_byte(wr * 64 + fr, fq * 8), boff = lds_byte(wc * 32 + fr, fq * 8);
#define PG8_SA(b, h) (((b) * 2 + (h)) * HTB)
#define PG8_SB(b, h) ((4 + (b) * 2 + (h)) * HTB)
#define PG8_STAGE(bufoff, gbase, voff) do { _Pragma("unroll") for (int _i = 0; _i < 2; ++_i) \
        __builtin_amdgcn_global_load_lds((const unsigned*)((const char*)(gbase) + (voff)[_i]), (PG8_LAS unsigned*)(lds + (bufoff) + ldsw + _i * 8192), 16, 0, 0); } while (0)
#define PG8_LDA(dst, b, h) do { _Pragma("unroll") for (int m = 0; m < 4; ++m) _Pragma("unroll") for (int k = 0; k < 2; ++k) dst[m][k] = *(const PG8_LAS bf16x8*)(lds + PG8_SA(b, h) + aoff + m * 2048 + k * 1024); } while (0)
#define PG8_LDB(dst, b, h) do { _Pragma("unroll") for (int n = 0; n < 2; ++n) _Pragma("unroll") for (int k = 0; k < 2; ++k) dst[n][k] = *(const PG8_LAS bf16x8*)(lds + PG8_SB(b, h) + boff + n * 2048 + k * 1024); } while (0)
#define PG8_MMA(ai, bj, At, Bt) do { __builtin_amdgcn_s_setprio(1); _Pragma("unroll") for (int m = 0; m < 4; ++m) _Pragma("unroll") for (int n = 0; n < 2; ++n) _Pragma("unroll") for (int k = 0; k < 2; ++k) \
        acc[ai][bj][m][n] = __builtin_amdgcn_mfma_f32_16x16x32_bf16(Bt[n][k], At[m][k], acc[ai][bj][m][n], 0, 0, 0); __builtin_amdgcn_s_setprio(0); } while (0)
#define PG8_WAIT_V(n) asm volatile("s_waitcnt vmcnt(" #n ")" ::: "memory")
#define PG8_WAIT_L(n) asm volatile("s_waitcnt lgkmcnt(" #n ")" ::: "memory")
#define PG8_BAR __builtin_amdgcn_s_barrier()
#define PG8_SCHED __builtin_amdgcn_sched_barrier(0)
    Unit cur, nxt; int ui = 0;
    if (!S.next(0, cur)) return;
    f32x4 acc[2][2][4][2];
#pragma unroll
    for (int a = 0; a < 2; ++a)
#pragma unroll
        for (int b = 0; b < 2; ++b)
#pragma unroll
            for (int m = 0; m < 4; ++m)
#pragma unroll
                for (int n = 0; n < 2; ++n) acc[a][b][m][n] = (f32x4){0.f, 0.f, 0.f, 0.f};
    bf16x8 At[4][2], B0[2][2], B1[2][2];
    if (!Sched::SPLITK) { cur.k0 = 0; cur.nk = nt_full; cur.which = 0; }
    const char* cA = (const char*)g.A + (size_t)cur.pm * tstep + (size_t)cur.k0 * (BK * 2); const char* cB = (const char*)g.Bt + (size_t)cur.pn * tstep + (size_t)cur.k0 * (BK * 2);
    S.a_ready(cur);
    if constexpr (SP2) {
        PG8_STAGE(PG8_SB(0, 0), cB, voffB); PG8_STAGE(PG8_SB(0, 1), cB + hstep, voffB); PG8_STAGE(PG8_SA(0, 0), cA, voffA); PG8_STAGE(PG8_SA(0, 1), cA + hstep, voffA);
        if (wr == 1) PG8_BAR;
        PG8_WAIT_V(2); PG8_BAR;
        PG8_STAGE(PG8_SB(1, 0), cB + kstep, voffB); PG8_STAGE(PG8_SA(1, 0), cA + kstep, voffA); PG8_STAGE(PG8_SB(1, 1), cB + hstep + kstep, voffB);
        PG8_WAIT_V(6); PG8_BAR;
    } else {
        PG8_STAGE(PG8_SB(0, 0), cB, voffB); PG8_STAGE(PG8_SA(0, 0), cA, voffA); PG8_STAGE(PG8_SB(0, 1), cB + hstep, voffB); PG8_STAGE(PG8_SA(0, 1), cA + hstep, voffA);
        if (wr == 1) PG8_BAR;
        PG8_WAIT_V(4); PG8_BAR;
        PG8_STAGE(PG8_SB(1, 0), cB + kstep, voffB); PG8_STAGE(PG8_SA(1, 0), cA + kstep, voffA); PG8_STAGE(PG8_SB(1, 1), cB + hstep + kstep, voffB);
        PG8_WAIT_V(6); PG8_BAR;
    }
    for (;;) {
        const bool has_next = S.next(ui + 1, nxt);
        if (!Sched::SPLITK) { nxt.k0 = 0; nxt.nk = nt_full; nxt.which = 0; }
        const char* nA = has_next ? (const char*)g.A + (size_t)nxt.pm * tstep + (size_t)nxt.k0 * (BK * 2) : cA; const char* nB = has_next ? (const char*)g.Bt + (size_t)nxt.pn * tstep + (size_t)nxt.k0 * (BK * 2) : cB;
        const int nt = cur.nk;
        for (int t = 0; t < nt; t += 2) {
            const bool last = (t == nt - 2);
            const char* a1 = cA + (size_t)(t + 1) * kstep;
            const char* a2 = last ? nA : cA + (size_t)(t + 2) * kstep; const char* b2 = last ? nB : cB + (size_t)(t + 2) * kstep;
            const char* a3 = a2 + kstep; const char* b3 = b2 + kstep;
            if (last && has_next) S.a_ready(nxt);
            if constexpr (SP2) {
            PG8_LDB(B0, 0, 0); PG8_LDB(B1, 0, 1); PG8_SCHED; PG8_LDA(At, 0, 0); PG8_STAGE(PG8_SA(1, 1), a1 + hstep, voffA);
            PG8_WAIT_V(8); PG8_WAIT_L(0); PG8_BAR; PG8_MMA(0, 0, At, B0); PG8_MMA(0, 1, At, B1); PG8_BAR; PG8_SCHED;
            PG8_LDA(At, 0, 1); PG8_STAGE(PG8_SB(0, 0), b2, voffB); PG8_STAGE(PG8_SB(0, 1), b2 + hstep, voffB); PG8_STAGE(PG8_SA(0, 0), a2, voffA);
            PG8_WAIT_V(8); PG8_WAIT_L(0); PG8_BAR; PG8_MMA(1, 0, At, B0); PG8_MMA(1, 1, At, B1); PG8_BAR; PG8_SCHED;
            PG8_LDB(B0, 1, 0); PG8_LDB(B1, 1, 1); PG8_SCHED; PG8_LDA(At, 1, 0); PG8_STAGE(PG8_SA(0, 1), a2 + hstep, voffA);
            PG8_WAIT_V(8); PG8_WAIT_L(0); PG8_BAR; PG8_MMA(0, 0, At, B0); PG8_MMA(0, 1, At, B1); PG8_BAR; PG8_SCHED;
            PG8_LDA(At, 1, 1); PG8_STAGE(PG8_SB(1, 0), b3, voffB); PG8_STAGE(PG8_SB(1, 1), b3 + hstep, voffB); PG8_STAGE(PG8_SA(1, 0), a3, voffA);
            PG8_WAIT_V(8); PG8_WAIT_L(0); PG8_BAR; PG8_MMA(1, 0, At, B0); PG8_MMA(1, 1, At, B1); PG8_BAR; PG8_SCHED;
            } else {
            PG8_LDB(B0, 0, 0); PG8_SCHED; PG8_LDA(At, 0, 0); PG8_STAGE(PG8_SA(1, 1), a1 + hstep, voffA);
            PG8_WAIT_L(8); PG8_BAR; PG8_WAIT_L(0); PG8_MMA(0, 0, At, B0); PG8_BAR; PG8_SCHED;
            PG8_LDB(B1, 0, 1); PG8_STAGE(PG8_SB(0, 0), b2, voffB);
            PG8_BAR; PG8_WAIT_L(0); PG8_MMA(0, 1, At, B1); PG8_BAR;
            PG8_LDA(At, 0, 1); PG8_STAGE(PG8_SA(0, 0), a2, voffA);
            PG8_BAR; PG8_WAIT_L(0); PG8_MMA(1, 0, At, B0); PG8_BAR; PG8_SCHED;
            PG8_STAGE(PG8_SB(0, 1), b2 + hstep, voffB);
            PG8_WAIT_V(6); PG8_BAR; PG8_MMA(1, 1, At, B1); PG8_BAR;
            PG8_LDB(B0, 1, 0); PG8_SCHED; PG8_LDA(At, 1, 0); PG8_STAGE(PG8_SA(0, 1), a2 + hstep, voffA);
            PG8_WAIT_L(8); PG8_BAR; PG8_WAIT_L(0); PG8_MMA(0, 0, At, B0); PG8_BAR; PG8_SCHED;
            PG8_LDB(B1, 1, 1); PG8_STAGE(PG8_SB(1, 0), b3, voffB);
            PG8_BAR; PG8_WAIT_L(0); PG8_MMA(0, 1, At, B1); PG8_BAR;
            PG8_LDA(At, 1, 1); PG8_STAGE(PG8_SA(1, 0), a3, voffA);
            PG8_BAR; PG8_WAIT_L(0); PG8_MMA(1, 0, At, B0); PG8_BAR; PG8_SCHED;
            PG8_STAGE(PG8_SB(1, 1), b3 + hstep, voffB);
            PG8_WAIT_V(6); PG8_BAR; PG8_MMA(1, 1, At, B1); PG8_BAR;
            }
        }
        if constexpr (ALIGN_EPI) { if (wr == 0) PG8_BAR; }
        if constexpr (!Epi::AFTER_DRAIN) { E(acc, cur, wr, wc, fr, fq); S.done(cur); }
        if (!has_next) break;
#pragma unroll
        for (int a = 0; a < 2; ++a)
#pragma unroll
            for (int b = 0; b < 2; ++b)
#pragma unroll
                for (int m = 0; m < 4; ++m)
#pragma unroll
                    for (int n = 0; n < 2; ++n) acc[a][b][m][n] = (f32x4){0.f, 0.f, 0.f, 0.f};
        cur = nxt; cA = nA; cB = nB; ++ui;
        if constexpr (ALIGN_EPI) { if (wr == 1) PG8_BAR; }
    }
    PG8_WAIT_V(0);
    if constexpr (!ALIGN_EPI) { if (wr == 0) PG8_BAR; }
    PG8_BAR;
    if constexpr (Epi::AFTER_DRAIN) { E.fused(acc, cur, wr, wc, fr, fq, lds, wid, lane); S.done(cur); }
#undef PG8_SA
#undef PG8_SB
#undef PG8_STAGE
#undef PG8_LDA
#undef PG8_LDB
#undef PG8_MMA
#undef PG8_WAIT_V
#undef PG8_WAIT_L
#undef PG8_BAR
#undef PG8_SCHED
}
}
constexpr int DM = 1024, MP = 16384, MS = 1024, MTOK = MP + MS, DFF = 2816, NGU = 2 * DFF, NIN = 1536, ZLD = 1280, DEPTH = 4;
constexpr int SEQ = 2048, DSEQ = 8, NB = 8, NDB = 128;
constexpr float RMS_EPS = 1e-6f, LN_EPS = 1e-5f;
constexpr size_t O_Y = 0, O_KP = 17825792, O_VP = 18350080, O_CP = 18874368, O_PP = 19120128, O_KS = 19243008, O_VS = 27631616, O_CS = 36020224, O_PS = 39952384, O_END = 41918464;
constexpr size_t MiB = 1u << 20;
constexpr size_t WS_WPAD = 128 * 1024;
constexpr size_t WS_W = 1 * MiB, W_LAYER = 38 * MiB;
constexpr size_t W_GU1 = 0, W_D1 = 11 * MiB, W_IN = 16 * MiB + MiB / 2, W_OUT = 19 * MiB + MiB / 2, W_GU2 = 21 * MiB + MiB / 2, W_D2 = 32 * MiB + MiB / 2;
constexpr size_t WS_U = WS_W + 4 * W_LAYER;
constexpr size_t WS_ACT = WS_U + 34 * MiB;
constexpr size_t WS_Z = WS_ACT, WS_MIX = WS_ACT + 48 * MiB;
constexpr size_t WS_D1 = WS_ACT + 94 * MiB;
constexpr size_t WS_HB = WS_D1 + 34 * MiB;
constexpr size_t WS_END = WS_HB + 34 * MiB;
static_assert((size_t)MTOK * DM * 2 <= 34 * MiB && (size_t)MTOK * DFF * 2 <= 94 * MiB && (size_t)MTOK * ZLD * 2 <= 48 * MiB && 48 * MiB + (size_t)MTOK * DM * 2 <= 94 * MiB, "ws map");
constexpr int LDS_BYTES = 147456;
#ifndef MK_DUP
#define MK_DUP 0
#endif
#define REP(bit) for (int rep_ = 0; rep_ < ((MK_DUP & (bit)) ? 2 : 1); ++rep_)
constexpr int NPH_FULL = 1 + 10 * DEPTH;
#ifndef MK_PH_HI
#define MK_PH_HI NPH_FULL
#endif
constexpr int NPH = MK_PH_HI;

#define LAS __attribute__((address_space(3)))
typedef unsigned short bf16;
typedef float f32x4 __attribute__((ext_vector_type(4)));
typedef short bf16x8 __attribute__((ext_vector_type(8)));
typedef unsigned u32x4 __attribute__((ext_vector_type(4)));
typedef unsigned u32x2 __attribute__((ext_vector_type(2)));
#define LDS_WAIT() asm volatile("s_waitcnt lgkmcnt(0)" ::: "memory")
using pg8::cvt_pk_bf16;
__device__ __forceinline__ void st_bf4_mfma(unsigned short* p, float __attribute__((ext_vector_type(4))) v) { unsigned __attribute__((ext_vector_type(2))) w; w.x = pg8::cvt_pk_s(v.x, v.y); w.y = pg8::cvt_pk_s(v.z, v.w); *(unsigned __attribute__((ext_vector_type(2)))*)p = w; }
__device__ __forceinline__ float bf2f(unsigned short b) { return __uint_as_float((unsigned)b << 16); }
__device__ __forceinline__ f32x4 ld_bf4(const bf16* p) { const u32x2 v = *(const u32x2*)p; f32x4 r; r.x = __uint_as_float(v.x << 16); r.y = __uint_as_float(v.x & 0xffff0000u); r.z = __uint_as_float(v.y << 16); r.w = __uint_as_float(v.y & 0xffff0000u); return r; }
__device__ __forceinline__ void st_bf4(bf16* p, f32x4 v) { u32x2 w; w.x = cvt_pk_bf16(v.x, v.y); w.y = cvt_pk_bf16(v.z, v.w); *(u32x2*)p = w; }
__device__ __forceinline__ float dpp_xadd(float v, int ctrl) { return v; }
template <int CTRL> __device__ __forceinline__ float dpp_add(float v) { return v + __builtin_bit_cast(float, __builtin_amdgcn_update_dpp(0, __builtin_bit_cast(int, v), CTRL, 0xf, 0xf, false)); }
__device__ __forceinline__ float wave_sum(float v) {
    v = dpp_add<0xB1>(v); v = dpp_add<0x4E>(v); v = dpp_add<0x141>(v); v = dpp_add<0x140>(v);
    const int b = __builtin_bit_cast(int, v);
    return (__builtin_bit_cast(float, __builtin_amdgcn_readlane(b, 0)) + __builtin_bit_cast(float, __builtin_amdgcn_readlane(b, 16))) + (__builtin_bit_cast(float, __builtin_amdgcn_readlane(b, 32)) + __builtin_bit_cast(float, __builtin_amdgcn_readlane(b, 48)));
}

struct Params { const float* in[23]; float* out; unsigned char* ws; int ph_lo, ph_hi; float one; int pad; };
enum { I_XP = 0, I_XS, I_SK, I_SV, I_SC, I_SP, I_NG, I_F1G, I_F1U, I_F1D, I_WIN, I_SINK, I_DWW, I_DWB, I_LNG, I_LNB, I_PW, I_POOLW, I_PSC, I_WOUT, I_F2G, I_F2U, I_F2D };

__device__ __forceinline__ void transpose_item(const float* __restrict__ W, int N, int k0, int n0, bf16* dst, int ldk, LAS float* scr, int lane) {
    float v[32];
#pragma unroll
    for (int i = 0; i < 32; ++i) { const int kk = 2 * i + (lane >> 5); v[i] = __builtin_nontemporal_load(W + (size_t)(k0 + kk) * N + n0 + (lane & 31)); }
#pragma unroll
    for (int i = 0; i < 32; ++i) { const int kk = 2 * i + (lane >> 5); scr[kk * 33 + (lane & 31)] = v[i]; }
    LDS_WAIT();
    const int c = lane & 7;
#pragma unroll
    for (int j = 0; j < 4; ++j) { const int n = (lane >> 3) + 8 * j; const LAS float* s = scr + (8 * c) * 33 + n;
        u32x4 o; o.x = cvt_pk_bf16(s[0 * 33], s[1 * 33]); o.y = cvt_pk_bf16(s[2 * 33], s[3 * 33]); o.z = cvt_pk_bf16(s[4 * 33], s[5 * 33]); o.w = cvt_pk_bf16(s[6 * 33], s[7 * 33]);
        *(u32x4*)(dst + (size_t)n * ldk + k0 + 8 * c) = o; }
    LDS_WAIT();
}
__device__ __forceinline__ int rowmap_gu(int n, int up) { return (n >> 7) * 256 + up * 128 + (n & 127); }
__device__ __forceinline__ int rowmap_in(int n) {
    if (n < 768 || n >= 1280) return n;
    if (n < 1024) { const int ch = n - 768; return 768 + (ch >> 7) * 256 + (ch & 127); }
    const int ch = n - 1024; return 768 + (ch >> 7) * 256 + 128 + (ch & 127);
}
template <bool HAS_D>
__device__ __forceinline__ void norm_row(const float* R, bf16* UD, float* H, const float* ga, float c, const float* gb, int lane, const bf16* P = nullptr, int nsl = 0) {
    f32x4 h[4];
#pragma unroll
    for (int j = 0; j < 4; ++j) h[j] = *(const f32x4*)(R + j * 256 + lane * 4);
    if (HAS_D) {
        f32x4 d[4]; float ss = 0.f;
#pragma unroll
        for (int j = 0; j < 4; ++j) { if (nsl == 0) d[j] = ld_bf4(UD + j * 256 + lane * 4); else { d[j] = ld_bf4(P + j * 256 + lane * 4); for (int s = 1; s < nsl; ++s) d[j] = d[j] + ld_bf4(P + (size_t)s * (1024 * 1024) + j * 256 + lane * 4); } ss += (d[j].x * d[j].x + d[j].y * d[j].y) + (d[j].z * d[j].z + d[j].w * d[j].w); }
        const float rstd = __builtin_amdgcn_rsqf(wave_sum(ss) * (1.f / DM) + RMS_EPS) * c;
#pragma unroll
        for (int j = 0; j < 4; ++j) { const f32x4 g = *(const f32x4*)(ga + j * 256 + lane * 4); h[j] = h[j] + d[j] * g * rstd; *(f32x4*)(H + j * 256 + lane * 4) = h[j]; }
    }
    if (gb) {
        float ss = 0.f;
#pragma unroll
        for (int j = 0; j < 4; ++j) ss += (h[j].x * h[j].x + h[j].y * h[j].y) + (h[j].z * h[j].z + h[j].w * h[j].w);
        const float rstd = __builtin_amdgcn_rsqf(wave_sum(ss) * (1.f / DM) + RMS_EPS);
#pragma unroll
        for (int j = 0; j < 4; ++j) { const f32x4 g = *(const f32x4*)(gb + j * 256 + lane * 4); st_bf4(UD + j * 256 + lane * 4, h[j] * g * rstd); }
    }
}

template <bool RBF> __device__ __forceinline__ f32x4 ld_res(const void* base, size_t off) { if (RBF) return ld_bf4((const bf16*)base + off); else return *(const f32x4*)((const float*)base + off); }
template <bool WF32> __device__ __forceinline__ void st_res(void* base, size_t off, f32x4 v) { if (WF32) *(f32x4*)((float*)base + off) = v; else st_bf4((bf16*)base + off, v); }
template <int NSL, bool RBF, bool WF32>
__device__ __forceinline__ void norm_phase(const void* Rp, const void* Rs, bf16* U, void* Hout, const bf16* P, const float* ga, float c, const float* gb, int gw, int ngw, int lane) {
    f32x4 gA[4], gB[4];
#pragma unroll
    for (int j = 0; j < 4; ++j) { gA[j] = *(const f32x4*)(ga + j * 256 + lane * 4) * c; gB[j] = gb ? *(const f32x4*)(gb + j * 256 + lane * 4) : (f32x4){0.f, 0.f, 0.f, 0.f}; }
    constexpr int RB = 2;
#pragma unroll 1
    for (int row0 = gw; row0 < MP; row0 += RB * ngw) {
        f32x4 h[RB][4], d[RB][4];
#pragma unroll
        for (int q = 0; q < RB; ++q) { const int row = row0 + q * ngw; if (row < MP) {
#pragma unroll
            for (int j = 0; j < 4; ++j) { h[q][j] = ld_res<RBF>(Rp, (size_t)row * DM + j * 256 + lane * 4); d[q][j] = ld_bf4(U + (size_t)row * DM + j * 256 + lane * 4); } } }
#pragma unroll
        for (int q = 0; q < RB; ++q) { const int row = row0 + q * ngw; if (row < MP) {
            float ss = 0.f;
#pragma unroll
            for (int j = 0; j < 4; ++j) ss += (d[q][j].x * d[q][j].x + d[q][j].y * d[q][j].y) + (d[q][j].z * d[q][j].z + d[q][j].w * d[q][j].w);
            const float rstd = __builtin_amdgcn_rsqf(wave_sum(ss) * (1.f / DM) + RMS_EPS);
            float s2 = 0.f;
#pragma unroll
            for (int j = 0; j < 4; ++j) { h[q][j] = h[q][j] + d[q][j] * gA[j] * rstd; st_res<WF32>(Hout, (size_t)row * DM + j * 256 + lane * 4, h[q][j]);
                s2 += (h[q][j].x * h[q][j].x + h[q][j].y * h[q][j].y) + (h[q][j].z * h[q][j].z + h[q][j].w * h[q][j].w); }
            if (gb) { const float r2 = __builtin_amdgcn_rsqf(wave_sum(s2) * (1.f / DM) + RMS_EPS);
#pragma unroll
                for (int j = 0; j < 4; ++j) st_bf4(U + (size_t)row * DM + j * 256 + lane * 4, h[q][j] * gB[j] * r2); } } }
    }
#pragma unroll 1
    for (int row = MP + gw; row < MTOK; row += ngw) {
        f32x4 h[4], d[4];
#pragma unroll
        for (int j = 0; j < 4; ++j) { h[j] = ld_res<RBF>(Rs, (size_t)(row - MP) * DM + j * 256 + lane * 4); d[j] = (f32x4){0.f, 0.f, 0.f, 0.f}; }
#pragma unroll
        for (int s = 0; s < NSL; ++s)
#pragma unroll
            for (int j = 0; j < 4; ++j) d[j] = d[j] + ld_bf4(P + (size_t)s * (1024 * 1024) + (size_t)(row - MP) * DM + j * 256 + lane * 4);
        float ss = 0.f;
#pragma unroll
        for (int j = 0; j < 4; ++j) ss += (d[j].x * d[j].x + d[j].y * d[j].y) + (d[j].z * d[j].z + d[j].w * d[j].w);
        const float rstd = __builtin_amdgcn_rsqf(wave_sum(ss) * (1.f / DM) + RMS_EPS);
        float s2 = 0.f;
#pragma unroll
        for (int j = 0; j < 4; ++j) { h[j] = h[j] + d[j] * gA[j] * rstd; st_res<WF32>(Hout, (size_t)row * DM + j * 256 + lane * 4, h[j]); s2 += (h[j].x * h[j].x + h[j].y * h[j].y) + (h[j].z * h[j].z + h[j].w * h[j].w); }
        if (gb) { const float r2 = __builtin_amdgcn_rsqf(wave_sum(s2) * (1.f / DM) + RMS_EPS);
#pragma unroll
            for (int j = 0; j < 4; ++j) st_bf4(U + (size_t)row * DM + j * 256 + lane * 4, h[j] * gB[j] * r2); }
    }
}
__device__ __forceinline__ unsigned hb_mask(int row, int ppu, int G) { const int T = (MTOK / 256) * 4 * ppu; unsigned m = 0u;
#pragma unroll
    for (int j = 0; j < 4; ++j) { const int un = (row >> 8) * 4 + j; const int c0 = ((un * ppu + 1) * G - 1) / T, c1 = (((un + 1) * ppu) * G - 1) / T; m |= (c0 != c1 ? 1u : 0u) << j; }
    return m; }
__device__ __forceinline__ const float* xrow(const Params& p, int row) { return row < MP ? p.in[I_XP] + (size_t)row * DM : p.in[I_XS] + (size_t)(row - MP) * DM; }


__device__ __forceinline__ void state_shift_copy(const Params& p, int l, int tix, int nthr) {
    constexpr int PER = 3840 + 3840 + 1408 + 448;
    for (int idx = tix; idx < NDB * PER; idx += nthr) { const int lb = l * NDB + idx / PER; int r = idx % PER; const float* src; float* dst;
        if (r < 3840) { src = p.in[I_SK] + (size_t)lb * 16384 + 1024 + r * 4; dst = p.out + O_KS + (size_t)lb * 16384 + r * 4; }
        else if (r < 7680) { r -= 3840; src = p.in[I_SV] + (size_t)lb * 16384 + 1024 + r * 4; dst = p.out + O_VS + (size_t)lb * 16384 + r * 4; }
        else if (r < 9088) { r -= 7680; src = p.in[I_SC] + (size_t)lb * 7680 + 2048 + r * 4; dst = p.out + O_CS + (size_t)lb * 7680 + r * 4; }
        else { r -= 9088; src = p.in[I_SP] + (size_t)lb * 3840 + 2048 + r * 4; dst = p.out + O_PS + (size_t)lb * 3840 + r * 4; }
        *(f32x4*)dst = *(const f32x4*)src; }
}

__device__ __forceinline__ void prologue(const Params& p, LAS unsigned char* lds, int gw, int ngw, int wave, int lane) {
    LAS float* scr = (LAS float*)(lds + wave * 16384);
    constexpr int I_FF = 16 * 88, I_WIN_N = 16 * 48, I_WO = 8 * 32, PER_L = 6 * I_FF + I_WIN_N + I_WO;
    for (int it = gw; it < DEPTH * PER_L; it += ngw) {
        const int l = it / PER_L; int r = it % PER_L;
        bf16* wl = (bf16*)(p.ws + WS_W + (size_t)l * W_LAYER);
        if (r < 6 * I_FF) {
            const int which = r / I_FF; r -= which * I_FF;
            const int half = which / 3, kind = which % 3;
            if (kind < 2) { const float* W = p.in[(half ? I_F2G : I_F1G) + kind] + (size_t)l * DM * DFF; const int kb = r / 88, nb = r % 88;
                bf16* dst = (bf16*)((unsigned char*)wl + (half ? W_GU2 : W_GU1)) + (size_t)rowmap_gu(nb * 32, kind) * DM;
                transpose_item(W, DFF, kb * 64, nb * 32, dst, DM, scr, lane); }
            else { const float* W = p.in[half ? I_F2D : I_F1D] + (size_t)l * DM * DFF; const int kb = r / 32, nb = r % 32;
                bf16* dst = (bf16*)((unsigned char*)wl + (half ? W_D2 : W_D1)) + (size_t)(nb * 32) * DFF;
                transpose_item(W, DM, kb * 64, nb * 32, dst, DFF, scr, lane); }
        } else if (r < 6 * I_FF + I_WIN_N) { r -= 6 * I_FF; const float* W = p.in[I_WIN] + (size_t)l * DM * NIN; const int kb = r / 48, nb = r % 48;
            bf16* dst = (bf16*)((unsigned char*)wl + W_IN) + (size_t)rowmap_in(nb * 32) * DM;
            transpose_item(W, NIN, kb * 64, nb * 32, dst, DM, scr, lane);
        } else { r -= 6 * I_FF + I_WIN_N; const float* W = p.in[I_WOUT] + (size_t)l * DM * DM; const int kb = r / 32, nb = r % 32;
            bf16* dst = (bf16*)((unsigned char*)wl + W_OUT) + (size_t)(nb * 32) * DM;
            transpose_item(W, DM, kb * 64, nb * 32, dst, DM, scr, lane); }
    }
    for (int fi0 = gw; fi0 < DEPTH * 1024; fi0 += ngw) {
        const int fi = (fi0 >= 2048) ? (fi0 ^ 512) : fi0;
        const int l = fi >> 10, kb = (fi & 1023) >> 4, n = (fi & 15) * 64 + lane;
        const float* wo = p.in[I_WOUT] + (size_t)l * DM * DM;
        float acc[8];
#pragma unroll
        for (int i = 0; i < 8; ++i) acc[i] = 0.f;
        if (kb < 32) {
            const float* pw = p.in[I_PW] + (size_t)l * 65536 + (size_t)(kb * 8) * 256; const float* wc = wo + (size_t)512 * DM + n;
#pragma unroll 1
            for (int j0 = 0; j0 < 256; j0 += 16) { float wv[16];
#pragma unroll
                for (int jj = 0; jj < 16; ++jj) wv[jj] = wc[(size_t)(j0 + jj) * DM];
#pragma unroll
                for (int jj = 0; jj < 16; ++jj)
#pragma unroll
                    for (int i = 0; i < 8; ++i) acc[i] += pw[i * 256 + j0 + jj] * wv[jj]; }
        } else {
            const int kk = (kb - 32) * 8, gi = kk >> 6, c0 = kk & 63;
            const float* pl = p.in[I_POOLW] + (size_t)l * 16384 + gi * 4096 + c0 * 64; const float* sc = p.in[I_PSC] + l * 256 + gi * 64; const float* wc = wo + (size_t)(768 + gi * 64) * DM + n;
#pragma unroll 1
            for (int d0 = 0; d0 < 64; d0 += 16) { float wv[16];
#pragma unroll
                for (int jj = 0; jj < 16; ++jj) wv[jj] = wc[(size_t)(d0 + jj) * DM] * sc[d0 + jj];
#pragma unroll
                for (int jj = 0; jj < 16; ++jj)
#pragma unroll
                    for (int i = 0; i < 8; ++i) acc[i] += pl[i * 64 + d0 + jj] * wv[jj]; }
        }
        u32x4 o; o.x = cvt_pk_bf16(acc[0], acc[1]); o.y = cvt_pk_bf16(acc[2], acc[3]); o.z = cvt_pk_bf16(acc[4], acc[5]); o.w = cvt_pk_bf16(acc[6], acc[7]);
        *(u32x4*)((bf16*)(p.ws + WS_W + (size_t)l * W_LAYER + W_OUT) + (size_t)n * DM + 512 + kb * 8) = o;
    }
    { float* wp = (float*)(p.ws + WS_WPAD); for (int idx = gw * 64 + lane; idx < DEPTH * 64 * 256; idx += ngw * 64) { const int l = idx >> 14, j = ((idx >> 8) & 63) - 15, c = idx & 255; wp[idx] = (j >= 0 && j <= 30) ? p.in[I_DWW][(size_t)l * 31 * 256 + j * 256 + c] : 0.f; } }
    bf16* U = (bf16*)(p.ws + WS_U);
    {
        f32x4 g0[4];
#pragma unroll
        for (int j = 0; j < 4; ++j) g0[j] = *(const f32x4*)(p.in[I_NG] + j * 256 + lane * 4);
#pragma unroll 1
        for (int row0 = gw; row0 < MTOK; row0 += 2 * ngw) {
            f32x4 h[2][4];
#pragma unroll
            for (int q = 0; q < 2; ++q) { const int row = row0 + q * ngw; if (row < MTOK) { const float* R = xrow(p, row);
#pragma unroll
                for (int j = 0; j < 4; ++j) h[q][j] = *(const f32x4*)(R + j * 256 + lane * 4); } }
#pragma unroll
            for (int q = 0; q < 2; ++q) { const int row = row0 + q * ngw; if (row < MTOK) { float ss = 0.f;
#pragma unroll
                for (int j = 0; j < 4; ++j) ss += (h[q][j].x * h[q][j].x + h[q][j].y * h[q][j].y) + (h[q][j].z * h[q][j].z + h[q][j].w * h[q][j].w);
                const float rstd = __builtin_amdgcn_rsqf(wave_sum(ss) * (1.f / DM) + RMS_EPS);
#pragma unroll
                for (int j = 0; j < 4; ++j) st_bf4(U + (size_t)row * DM + j * 256 + lane * 4, h[q][j] * g0[j] * rstd); } }
        }
    }
}

constexpr int KSTR = 72, VSTR = 264, KTILE = 256 * KSTR, VTILE = 64 * VSTR, VT_OFF = 2 * KTILE * 2;
static_assert(VT_OFF + 2 * VTILE * 2 <= LDS_BYTES, "attention LDS");
template <int NKB>
__device__ __forceinline__ void attn_wave(const LAS bf16* Ks, const LAS bf16* Vt, const bf16x8 qf0, const bf16x8 qf1, int qi, int j0, int lim, float slope, float sink, bf16* optr, int fr, int fq) {
    constexpr float LOG2E = 1.44269504f;
    bf16x8 qf[2]; qf[0] = qf0; qf[1] = qf1;
    f32x4 s[NKB];
#pragma unroll
    for (int kb = 0; kb < NKB; ++kb) { s[kb] = (f32x4){0.f, 0.f, 0.f, 0.f};
#pragma unroll
        for (int kc = 0; kc < 2; ++kc) { const bf16x8 a = *(const LAS bf16x8*)(Ks + (kb * 16 + fr) * KSTR + kc * 32 + fq * 8); s[kb] = __builtin_amdgcn_mfma_f32_16x16x32_bf16(a, qf[kc], s[kb], 0, 0, 0); } }
    const int base = qi + 128 - j0 - 4 * fq; const float slope2 = slope * LOG2E, b0 = -slope2 * (float)base, sink2 = sink * LOG2E;
    float mx = -1e30f;
#pragma unroll
    for (int kb = 0; kb < NKB; ++kb)
#pragma unroll
        for (int i = 0; i < 4; ++i) { const int c = kb * 16 + i; const bool valid = (unsigned)(base - c) < (unsigned)lim;
            const float lg = valid ? __builtin_fmaf(s[kb][i], 0.125f * LOG2E, __builtin_fmaf(slope2, (float)c, b0)) : -1e30f; s[kb][i] = lg; mx = fmaxf(mx, lg); }
    mx = fmaxf(mx, __shfl_xor(mx, 16)); mx = fmaxf(mx, __shfl_xor(mx, 32)); mx = fmaxf(mx, sink2);
    float sum = 0.f;
#pragma unroll
    for (int kb = 0; kb < NKB; ++kb)
#pragma unroll
        for (int i = 0; i < 4; ++i) { const float e = __builtin_amdgcn_exp2f(s[kb][i] - mx); s[kb][i] = e; sum += e; }
    sum += __shfl_xor(sum, 16); sum += __shfl_xor(sum, 32);
    const float inv = 1.0f / (sum + __builtin_amdgcn_exp2f(sink2 - mx));
    bf16x8 pf[NKB / 2];
#pragma unroll
    for (int kc = 0; kc < NKB / 2; ++kc) { u32x4 w; w.x = cvt_pk_bf16(s[2 * kc][0] * inv, s[2 * kc][1] * inv); w.y = cvt_pk_bf16(s[2 * kc][2] * inv, s[2 * kc][3] * inv);
        w.z = cvt_pk_bf16(s[2 * kc + 1][0] * inv, s[2 * kc + 1][1] * inv); w.w = cvt_pk_bf16(s[2 * kc + 1][2] * inv, s[2 * kc + 1][3] * inv); pf[kc] = __builtin_bit_cast(bf16x8, w); }
#pragma unroll
    for (int db = 0; db < 4; ++db) { f32x4 o = (f32x4){0.f, 0.f, 0.f, 0.f};
#pragma unroll
        for (int kc = 0; kc < NKB / 2; ++kc) { const LAS bf16* vp = Vt + (db * 16 + fr) * VSTR + kc * 32 + 4 * fq;
            const u32x2 lo = *(const LAS u32x2*)vp, hi = *(const LAS u32x2*)(vp + 16); u32x4 a; a.x = lo.x; a.y = lo.y; a.z = hi.x; a.w = hi.y;
            o = __builtin_amdgcn_mfma_f32_16x16x32_bf16(__builtin_bit_cast(bf16x8, a), pf[kc], o, 0, 0, 0); }
        st_bf4_mfma(optr + db * 16 + 4 * fq, o); }
}


template <bool SAMP, int NT>
__device__ __forceinline__ void convpool_unit(const Params& p, const bf16* Z, bf16* MIX, int l, int row0, int b, int t0, int lane_in) {
    int lane = lane_in; asm volatile("" : "+v"(lane));
    const int ch = lane * 4;
    const f32x4 zero4 = (f32x4){0.f, 0.f, 0.f, 0.f};
    {
        const float* dw = (const float*)(p.ws + WS_WPAD) + (size_t)l * 64 * 256 + 15 * 256 + ch;
        const float* sc = p.in[I_SC] + (size_t)(l * NDB + b) * 30 * 256 + ch;
        const bf16* zg = Z + (size_t)(SAMP ? MP + b * DSEQ : b * SEQ) * ZLD + 768 + ch;
        constexpr int NROW = 30 + NT, NRB = (NROW + 7) / 8 * 8;
        f32x4 acc[NT];
#pragma unroll
        for (int tt = 0; tt < NT; ++tt) acc[tt] = zero4;
        u32x2 nv[8];
        if (!SAMP) {
#pragma unroll
            for (int i = 0; i < 8; ++i) { const int t = t0 + i - 30, tc = t < 0 ? 0 : t; nv[i] = *(const u32x2*)(zg + (size_t)tc * ZLD); } }
#pragma unroll 1
        for (int r0 = 0; r0 < NRB; r0 += 8) {
            f32x4 val[8];
#pragma unroll
            for (int i = 0; i < 8; ++i) { const int r = r0 + i;
                if (SAMP) { const int rs = r < 29 ? r : 29, rz = r < 30 ? 0 : (r > 37 ? 7 : r - 30); const f32x4 a = *(const f32x4*)(sc + rs * 256), z = ld_bf4(zg + (size_t)rz * ZLD); val[i] = r < 30 ? a : z; }
                else { const int t = t0 + r - 30; f32x4 z; z.x = __uint_as_float(nv[i].x << 16); z.y = __uint_as_float(nv[i].x & 0xffff0000u); z.z = __uint_as_float(nv[i].y << 16); z.w = __uint_as_float(nv[i].y & 0xffff0000u); val[i] = t >= 0 ? z : zero4; } }
            if (!SAMP) {
#pragma unroll
                for (int i = 0; i < 8; ++i) { const int t = t0 + r0 + 8 + i - 30, tc = t < 0 ? 0 : (t > SEQ - 1 ? SEQ - 1 : t); nv[i] = *(const u32x2*)(zg + (size_t)tc * ZLD); } }
#pragma unroll
            for (int hh = 0; hh < NT / 8; ++hh) {
                f32x4 wb[15];
#pragma unroll
                for (int k = 0; k < 15; ++k) wb[k] = *(const f32x4*)(dw + (r0 - 8 * hh - 7 + k) * 256);
#pragma unroll
                for (int i = 0; i < 8; ++i)
#pragma unroll
                    for (int tt = 0; tt < 8; ++tt) acc[8 * hh + tt] += wb[i - tt + 7] * val[i];
            }
#pragma unroll
            for (int i = 0; i < 8; ++i) { const int r = r0 + i; if (r >= 30 && r < NROW) { const int tok = r - 30;
                if (SAMP) *(f32x4*)(p.out + O_CS + ((size_t)(l * NDB + b) * 30 + 22 + tok) * 256 + ch) = val[i];
                else if (t0 + tok >= SEQ - 30) *(f32x4*)(p.out + O_CP + ((size_t)(l * NB + b) * 30 + (t0 + tok - (SEQ - 30))) * 256 + ch) = val[i]; } }
        }
        const f32x4 bias = *(const f32x4*)(p.in[I_DWB] + l * 256 + ch), lg = *(const f32x4*)(p.in[I_LNG] + l * 256 + ch), lb = *(const f32x4*)(p.in[I_LNB] + l * 256 + ch);
#pragma unroll
        for (int tt = 0; tt < NT; ++tt) { const f32x4 c = acc[tt] + bias; const float mean = wave_sum((c.x + c.y) + (c.z + c.w)) * (1.f / 256.f); const f32x4 d = c - mean;
            const float var = wave_sum((d.x * d.x + d.y * d.y) + (d.z * d.z + d.w * d.w)) * (1.f / 256.f); const float rstd = __builtin_amdgcn_rsqf(var + LN_EPS);
            f32x4 y = d * rstd * lg + lb; y.x *= pg8::sigmoidf_fast(y.x); y.y *= pg8::sigmoidf_fast(y.y); y.z *= pg8::sigmoidf_fast(y.z); y.w *= pg8::sigmoidf_fast(y.w);
            st_bf4(MIX + (size_t)(row0 + tt) * DM + 512 + ch, y); }
    }
    {
        const int wsz = 2 << (lane >> 4);
        const float f4 = wsz >= 4 ? 1.f : 0.f, f8 = wsz >= 8 ? 1.f : 0.f, f16 = wsz >= 16 ? 1.f : 0.f;
        const float* sp = p.in[I_SP] + (size_t)(l * NDB + b) * 15 * 256 + ch;
        const bf16* zp = Z + (size_t)(SAMP ? MP + b * DSEQ : b * SEQ) * ZLD + 1024 + ch;
        constexpr int NROW = 15 + NT, NRB = (NROW + 7) / 8 * 8;
        f32x4 acc[NT];
#pragma unroll
        for (int tt = 0; tt < NT; ++tt) acc[tt] = zero4;
#pragma unroll
        for (int r0 = 0; r0 < NRB; r0 += 8) {
            f32x4 val[8];
#pragma unroll
            for (int i = 0; i < 8; ++i) { const int r = r0 + i;
                if (SAMP) { const int rs = r < 14 ? r : 14, rz = r < 15 ? 0 : (r > 22 ? 7 : r - 15); if (r < 15) val[i] = *(const f32x4*)(sp + rs * 256); else val[i] = ld_bf4(zp + (size_t)rz * ZLD); }
                else { const int t = t0 + r - 15, tc = t < 0 ? 0 : (t > SEQ - 1 ? SEQ - 1 : t); const f32x4 z = ld_bf4(zp + (size_t)tc * ZLD); val[i] = t >= 0 ? z : zero4; } }
#pragma unroll
            for (int i = 0; i < 8; ++i)
#pragma unroll
                for (int tt = 0; tt < NT; ++tt) { const int ii = 15 + tt - (r0 + i);
                    if (ii == 0) { const int pos = SAMP ? 8192 + tt : t0 + tt; const int cnt = wsz < pos + 1 ? wsz : pos + 1; acc[tt] += val[i] * (1.f - (float)cnt); }
                    else if (ii == 1) acc[tt] += val[i];
                    else if (ii >= 2 && ii < 4) acc[tt] += val[i] * f4;
                    else if (ii >= 4 && ii < 8) acc[tt] += val[i] * f8;
                    else if (ii >= 8 && ii < 16) acc[tt] += val[i] * f16; }
#pragma unroll
            for (int i = 0; i < 8; ++i) { const int r = r0 + i; if (r >= 15 && r < NROW) { const int tok = r - 15;
                if (SAMP) *(f32x4*)(p.out + O_PS + ((size_t)(l * NDB + b) * 15 + 7 + tok) * 256 + ch) = val[i];
                else if (t0 + tok >= SEQ - 15) *(f32x4*)(p.out + O_PP + ((size_t)(l * NB + b) * 15 + (t0 + tok - (SEQ - 15))) * 256 + ch) = val[i]; } }
            asm volatile("" ::: "memory");
        }
#pragma unroll
        for (int tt = 0; tt < NT; ++tt) { const int pos = SAMP ? 8192 + tt : t0 + tt; const int cnt = wsz < pos + 1 ? wsz : pos + 1; const float ic = 1.0f / (float)cnt;
            st_bf4(MIX + (size_t)(row0 + tt) * DM + 768 + ch, acc[tt] * ic); }
    }
}

__device__ __forceinline__ void mixer_phase(const Params& p, LAS unsigned char* lds, int l, int gw, int ngw, int wave, int lane, int tid) {
    const bf16* Z = (const bf16*)(p.ws + WS_Z); bf16* MIX = (bf16*)(p.ws + WS_MIX);
    LAS bf16* Ks = (LAS bf16*)lds; LAS bf16* Vt = (LAS bf16*)(lds + VT_OFF);
    const int fr = lane & 15, fq = lane >> 4;
    const float* sinks = p.in[I_SINK] + l * 8;
    for (int uid = blockIdx.x; uid < 256 + NDB; uid += gridDim.x) {
        __syncthreads();
        if (uid < 256) {
            const int b = uid >> 5, qb = (uid >> 1) & 15, kv = uid & 1;
            u32x4 k4s[4], v4s[4];
#pragma unroll
            for (int it = 0; it < 4; ++it) { const int c = tid + it * 512, j = c >> 3, dc = (c & 7) * 8, t = qb * 128 - 128 + j;
                k4s[it] = (u32x4){0u, 0u, 0u, 0u}; v4s[it] = k4s[it];
                if (t >= 0) { const bf16* zr = Z + (size_t)(b * SEQ + t) * ZLD; k4s[it] = *(const u32x4*)(zr + 512 + kv * 64 + dc); v4s[it] = *(const u32x4*)(zr + 640 + kv * 64 + dc); } }
#pragma unroll
            for (int it = 0; it < 4; ++it) { const int c = tid + it * 512, j = c >> 3, dc = (c & 7) * 8; const u32x4 k4 = k4s[it], v4 = v4s[it];
                *(LAS u32x4*)(Ks + j * KSTR + dc) = k4;
                const unsigned vv[4] = {v4.x, v4.y, v4.z, v4.w};
#pragma unroll
                for (int e = 0; e < 4; ++e) { Vt[(dc + 2 * e) * VSTR + j] = (bf16)(vv[e] & 0xffffu); Vt[(dc + 2 * e + 1) * VSTR + j] = (bf16)(vv[e] >> 16); }
                if (qb == 15 && j >= 128) { const size_t o = ((size_t)(l * NB + b) * 128 + (j - 128)) * 128 + kv * 64 + dc; float* ko = p.out + O_KP + o; float* vo = p.out + O_VP + o;
                    const unsigned kk[4] = {k4.x, k4.y, k4.z, k4.w};
                    *(f32x4*)ko = (f32x4){__uint_as_float(kk[0] << 16), __uint_as_float(kk[0] & 0xffff0000u), __uint_as_float(kk[1] << 16), __uint_as_float(kk[1] & 0xffff0000u)};
                    *(f32x4*)(ko + 4) = (f32x4){__uint_as_float(kk[2] << 16), __uint_as_float(kk[2] & 0xffff0000u), __uint_as_float(kk[3] << 16), __uint_as_float(kk[3] & 0xffff0000u)};
                    *(f32x4*)vo = (f32x4){__uint_as_float(vv[0] << 16), __uint_as_float(vv[0] & 0xffff0000u), __uint_as_float(vv[1] << 16), __uint_as_float(vv[1] & 0xffff0000u)};
                    *(f32x4*)(vo + 4) = (f32x4){__uint_as_float(vv[2] << 16), __uint_as_float(vv[2] & 0xffff0000u), __uint_as_float(vv[3] << 16), __uint_as_float(vv[3] & 0xffff0000u)}; }
            }
            __syncthreads();
            const int g = wave >> 1, h = kv * 4 + g; const float slope = __builtin_amdgcn_exp2f(-(float)(h + 1)), sink = sinks[h];
            const bf16* qp0 = Z + ((size_t)b * SEQ + qb * 128 + (wave & 1) * 64 + fr) * ZLD + h * 64 + fq * 8;
            bf16x8 q0 = *(const bf16x8*)qp0, q1 = *(const bf16x8*)(qp0 + 32);
#pragma unroll 1
            for (int qq = 0; qq < 4; ++qq) { const int qi = (wave & 1) * 64 + qq * 16 + fr; const size_t row = (size_t)b * SEQ + qb * 128 + qi;
                const bf16* qn = qp0 + (size_t)((qq + 1) & 3) * 16 * ZLD; const bf16x8 n0 = *(const bf16x8*)qn, n1 = *(const bf16x8*)(qn + 32);
                const int j0 = (((wave & 1) * 4 + qq) & ~1) * 16;
                attn_wave<10>(Ks + j0 * KSTR, Vt + j0, q0, q1, qi, j0, qb == 0 ? qi + 1 : 128, slope, sink, MIX + row * DM + h * 64, fr, fq); q0 = n0; q1 = n1; }
        } else {
            const int b = uid - 256;
            for (int c = tid; c < 160 * 16; c += 512) { const int j = c >> 4, kvh = (c >> 3) & 1, dc = (c & 7) * 8;
                u32x4 k4 = (u32x4){0u, 0u, 0u, 0u}, v4 = k4;
                if (j < 128) { const size_t o = ((size_t)(l * NDB + b) * 128 + j) * 128 + kvh * 64 + dc; const float* ks = p.in[I_SK] + o; const float* vs = p.in[I_SV] + o;
                    const f32x4 a0 = *(const f32x4*)ks, a1 = *(const f32x4*)(ks + 4), b0 = *(const f32x4*)vs, b1 = *(const f32x4*)(vs + 4);
                    k4.x = cvt_pk_bf16(a0.x, a0.y); k4.y = cvt_pk_bf16(a0.z, a0.w); k4.z = cvt_pk_bf16(a1.x, a1.y); k4.w = cvt_pk_bf16(a1.z, a1.w);
                    v4.x = cvt_pk_bf16(b0.x, b0.y); v4.y = cvt_pk_bf16(b0.z, b0.w); v4.z = cvt_pk_bf16(b1.x, b1.y); v4.w = cvt_pk_bf16(b1.z, b1.w); }
                else if (j < 136) { const bf16* zr = Z + (size_t)(MP + b * DSEQ + (j - 128)) * ZLD; k4 = *(const u32x4*)(zr + 512 + kvh * 64 + dc); v4 = *(const u32x4*)(zr + 640 + kvh * 64 + dc);
                    const size_t o = ((size_t)(l * NDB + b) * 128 + 120 + (j - 128)) * 128 + kvh * 64 + dc; float* ko = p.out + O_KS + o; float* vo = p.out + O_VS + o;
                    const unsigned kk[4] = {k4.x, k4.y, k4.z, k4.w}, vv2[4] = {v4.x, v4.y, v4.z, v4.w};
                    *(f32x4*)ko = (f32x4){__uint_as_float(kk[0] << 16), __uint_as_float(kk[0] & 0xffff0000u), __uint_as_float(kk[1] << 16), __uint_as_float(kk[1] & 0xffff0000u)};
                    *(f32x4*)(ko + 4) = (f32x4){__uint_as_float(kk[2] << 16), __uint_as_float(kk[2] & 0xffff0000u), __uint_as_float(kk[3] << 16), __uint_as_float(kk[3] & 0xffff0000u)};
                    *(f32x4*)vo = (f32x4){__uint_as_float(vv2[0] << 16), __uint_as_float(vv2[0] & 0xffff0000u), __uint_as_float(vv2[1] << 16), __uint_as_float(vv2[1] & 0xffff0000u)};
                    *(f32x4*)(vo + 4) = (f32x4){__uint_as_float(vv2[2] << 16), __uint_as_float(vv2[2] & 0xffff0000u), __uint_as_float(vv2[3] << 16), __uint_as_float(vv2[3] & 0xffff0000u)}; }
                *(LAS u32x4*)(Ks + kvh * KTILE + j * KSTR + dc) = k4;
                const unsigned vv[4] = {v4.x, v4.y, v4.z, v4.w};
#pragma unroll
                for (int e = 0; e < 4; ++e) { Vt[kvh * VTILE + (dc + 2 * e) * VSTR + j] = (bf16)(vv[e] & 0xffffu); Vt[kvh * VTILE + (dc + 2 * e + 1) * VSTR + j] = (bf16)(vv[e] >> 16); }
            }
            __syncthreads();
            if (wave < 4) { const int kvh = wave >> 1, rr = (wave & 1) * 16 + fr, qi = rr & 7, h = kvh * 4 + (rr >> 3);
                const float slope = __builtin_amdgcn_exp2f(-(float)(h + 1)), sink = sinks[h]; const size_t row = (size_t)MP + b * DSEQ + qi;
                const bf16* qp = Z + row * ZLD + h * 64;
                attn_wave<10>(Ks + kvh * KTILE, Vt + kvh * VTILE, *(const bf16x8*)(qp + fq * 8), *(const bf16x8*)(qp + 32 + fq * 8), qi, 0, 128, slope, sink, MIX + row * DM + h * 64, fr, fq); }
        }
    }
    if (ngw == 2048) {
        if (blockIdx.x >= 128) { const int unit = ((int)blockIdx.x - 128) * 8 + wave; convpool_unit<false, 16>(p, Z, MIX, l, unit * 16, unit >> 7, (unit & 127) * 16, lane); }
        else if (wave == 4) { const int sb = (int)blockIdx.x; convpool_unit<true, 8>(p, Z, MIX, l, MP + sb * 8, sb, 0, lane); }
    } else {
        for (int unit = gw; unit < MP / 16 + NDB; unit += ngw) {
            if (unit < MP / 16) convpool_unit<false, 16>(p, Z, MIX, l, unit * 16, unit >> 7, (unit & 127) * 16, lane);
            else convpool_unit<true, 8>(p, Z, MIX, l, MP + (unit - MP / 16) * 8, unit - MP / 16, 0, lane);
        }
    }
}

#define XB_TMO      128
#define XB_XCNT(j)  (256  + 64 * (j))
#define XB_XSUB(j)  (1280 + 64 * (j))
#define XB_XGEN(j)  (2304 + 64 * (j))
#define XB_TOP      3328
#define XB_TOPGEN   3392
#define XCD_BAR_WORDS 3456
#define XB_SPIN_CAP (1u << 18)
__device__ __forceinline__ unsigned xb_ld(unsigned* p)              { return __hip_atomic_load(p, __ATOMIC_RELAXED, __HIP_MEMORY_SCOPE_AGENT); }
__device__ __forceinline__ unsigned xb_add(unsigned* p, unsigned v) { return __hip_atomic_fetch_add(p, v, __ATOMIC_RELAXED, __HIP_MEMORY_SCOPE_AGENT); }
__device__ __forceinline__ unsigned xb_xcc_id() { return (unsigned)__builtin_amdgcn_s_getreg((3 << 11) | 20) & 0xFu; }
#define XB_SPIN(cond, bar) do { unsigned _sp = 0; while (cond) { __builtin_amdgcn_s_sleep(1); \
    if ((++_sp & 255u) == 0u) { if (xb_ld(&(bar)[XB_TMO])) break; if (_sp > XB_SPIN_CAP) { atomicAdd(&(bar)[XB_TMO], 1u); break; } } } } while (0)
struct XcdBarrier { unsigned* bar; unsigned x; volatile LAS unsigned* st; };
__device__ __forceinline__ XcdBarrier xcd_barrier_post(unsigned* bar, volatile LAS unsigned* st) {
    XcdBarrier b; b.bar = bar; b.x = xb_xcc_id(); b.st = st;
    if (threadIdx.x == 0) (void)xb_add(&bar[XB_XCNT(b.x)], 1u);
    return b;
}
__device__ __forceinline__ void xcd_barrier_complete(unsigned* bar, unsigned x, unsigned& nloc, unsigned& nx) {
    const unsigned G = gridDim.x * gridDim.y * gridDim.z;
    unsigned sum, cnt, mine, sp = 0u;
    for (;;) {
        sum = 0u; cnt = 0u; mine = 0u;
#pragma unroll
        for (unsigned j = 0; j < 16; ++j) { const unsigned c = xb_ld(&bar[XB_XCNT(j)]); sum += c; cnt += (c > 0u) ? 1u : 0u; mine = (j == x) ? c : mine; }
        if (sum == G) break;
        __builtin_amdgcn_s_sleep(1);
        if ((++sp & 255u) == 0u) { if (xb_ld(&bar[XB_TMO])) break; if (sp > XB_SPIN_CAP) { atomicAdd(&bar[XB_TMO], 1u); break; } }
    }
    nloc = mine > 0u ? mine : 1u; nx = cnt > 0u ? cnt : 1u;
}
__device__ __forceinline__ void xcd_barrier(const XcdBarrier& b) {
    asm volatile("s_waitcnt vmcnt(0)" ::: "memory");
    __syncthreads();
    if (threadIdx.x == 0) {
        unsigned* bar = b.bar;
        __builtin_amdgcn_s_waitcnt(0);
        unsigned nloc = b.st[0], nx = b.st[1];
        if (nloc == 0u) { xcd_barrier_complete(bar, b.x, nloc, nx); b.st[0] = nloc; b.st[1] = nx; }
        const unsigned old = xb_add(&bar[XB_XSUB(b.x)], 1u);
        const unsigned gen = old / nloc;
        if (old + 1u == (gen + 1u) * nloc) {
            __builtin_amdgcn_fence(__ATOMIC_RELEASE, "agent");
            asm volatile("s_waitcnt vmcnt(0)" ::: "memory");
            const unsigned og = xb_add(&bar[XB_TOP], 1u);
            const unsigned tg = og / nx;
            if (og + 1u == (tg + 1u) * nx) xb_add(&bar[XB_TOPGEN], 1u);
            else XB_SPIN(xb_ld(&bar[XB_TOPGEN]) == tg, bar);
            __builtin_amdgcn_fence(__ATOMIC_ACQUIRE, "agent");
            xb_add(&bar[XB_XGEN(b.x)], 1u);
            asm volatile("s_waitcnt vmcnt(0)" ::: "memory");
        } else {
            XB_SPIN(xb_ld(&bar[XB_XGEN(b.x)]) == gen, bar);
            __builtin_amdgcn_fence(__ATOMIC_ACQUIRE, "agent");
            asm volatile("s_waitcnt vmcnt(0)" ::: "memory");
        }
    }
    __syncthreads();
}

__global__ void __launch_bounds__(512, 2) mega_fwd(Params p) {
    extern __shared__ __attribute__((aligned(16))) unsigned char lds_raw[];
    LAS unsigned char* lds = (LAS unsigned char*)lds_raw;
    cg::grid_group grid = cg::this_grid();
    const int lo = p.ph_lo, hi = p.ph_hi;
    const int ngw = gridDim.x * 8;
    unsigned* barw = (unsigned*)p.ws;
    volatile LAS unsigned* bst = (volatile LAS unsigned*)(lds + LDS_BYTES - 16);
    if (threadIdx.x == 0) { bst[0] = 0u; bst[1] = 0u; }
    __syncthreads();
    XcdBarrier xbar = xcd_barrier_post(barw, bst);
    if (hi == -12345) grid.sync();
    const float one = p.one;
#define FRESH() int tid_ = threadIdx.x; asm volatile("" : "+v"(tid_)); const int lane = tid_ & 63, wave = __builtin_amdgcn_readfirstlane(tid_ >> 6), gw = blockIdx.x * 8 + wave
#define IN(k) (lo <= (k) && (k) < hi)
#define SEAM(k) do { if (lo <= (k) && (k) + 1 < hi) { xcd_barrier(xbar); if (MK_DUP & 64) xcd_barrier(xbar); } } while (0)
    bf16* U = (bf16*)(p.ws + WS_U); bf16* ACT = (bf16*)(p.ws + WS_ACT); bf16* Zb = (bf16*)(p.ws + WS_Z); bf16* MIX = (bf16*)(p.ws + WS_MIX);
    float* H = p.out; const bf16* D1b = (const bf16*)(p.ws + WS_D1); bf16* Hb = (bf16*)(p.ws + WS_HB);
    const int vcu = (gridDim.x % 8 == 0) ? (int)(blockIdx.x % 8) * (int)(gridDim.x / 8) + (int)(blockIdx.x / 8) : (int)blockIdx.x;
    if (IN(0)) REP(1) { FRESH(); prologue(p, lds, gw, ngw, wave, lane); }
    SEAM(0);
#pragma unroll 1
    for (int l = 0; l < DEPTH; ++l) {
        const int pb = 1 + 10 * l;
        const unsigned char* wl = p.ws + WS_W + (size_t)l * W_LAYER;
        const float* ng = p.in[I_NG] + (size_t)l * 6 * DM;
#pragma unroll 1
        for (int half = 0; half < 2; ++half) {
            const int hb = pb + (half ? 7 : 0);
            if (IN(hb)) REP(2) {
                pg8::Gemm g{U, (const bf16*)(wl + (half ? W_GU2 : W_GU1)), MTOK, NGU, DM}; pg8::StaticOrder S; S.init(MTOK, NGU, gridDim.x, blockIdx.x);
                pg8::EpiSwiGLU E{ACT, DFF};
                pg8::gemm_phase<pg8::EpiSwiGLU, pg8::StaticOrder, true, true>(lds, g, S, E);
            }
            SEAM(hb);
            if (IN(hb + 1)) REP(4) {
                pg8::Gemm g{ACT, (const bf16*)(wl + (half ? W_D2 : W_D1)), MTOK, DM, DFF}; pg8::HybridOrder S; S.init(DFF, gridDim.x, blockIdx.x);
                pg8::EpiPlain E{U, DM, one, (WS_D1 - WS_U) / 2};
                pg8::gemm_phase<pg8::EpiPlain, pg8::HybridOrder, true, true>(lds, g, S, E);
            }
            SEAM(hb + 1);
            if (IN(hb + 2)) {
                FRESH();
                const float* ga = ng + (half ? 5 : 1) * DM; const float* gb = half ? (l + 1 < DEPTH ? ng + 6 * DM : nullptr) : ng + 2 * DM;
                if (l == 0 && half == 0) norm_phase<PG8_NSL_MAX, false, false>(p.in[I_XP], p.in[I_XS], U, Hb, D1b, ga, 0.5f, gb, gw, ngw, lane);
                else if (l == DEPTH - 1 && half == 1) norm_phase<PG8_NSL_MAX, true, true>(Hb, Hb + (size_t)MP * DM, U, H, D1b, ga, 0.5f, gb, gw, ngw, lane);
                else norm_phase<PG8_NSL_MAX, true, false>(Hb, Hb + (size_t)MP * DM, U, Hb, D1b, ga, 0.5f, gb, gw, ngw, lane);
            }
            SEAM(hb + 2);
            if (half == 0) {
                if (IN(pb + 3)) REP(8) {
                    pg8::Gemm g{U, (const bf16*)(wl + W_IN), MTOK, NIN, DM}; pg8::StaticOrder S; S.init(MTOK, NIN, gridDim.x, blockIdx.x);
                    pg8::EpiZ E{Zb, ZLD, one};
                    pg8::gemm_phase<pg8::EpiZ, pg8::StaticOrder, true, true>(lds, g, S, E);
                    { constexpr int NU = (MTOK / 256) * (NIN / 256); const int nfull = NU % (int)gridDim.x;
                      FRESH(); if (rep_ == 0) { if (nfull > 0 && (int)blockIdx.x >= nfull) state_shift_copy(p, l, ((int)blockIdx.x - nfull) * 512 + tid_, ((int)gridDim.x - nfull) * 512); else if (nfull == 0) state_shift_copy(p, l, (int)blockIdx.x * 512 + tid_, (int)gridDim.x * 512); } (void)lane; (void)wave; (void)gw; }
                }
                SEAM(pb + 3);
                if (IN(pb + 4)) REP(16) { FRESH(); mixer_phase(p, lds, l, gw, ngw, wave, lane, tid_); }
                SEAM(pb + 4);
                if (IN(pb + 5)) REP(32) {
                    pg8::Gemm g{MIX, (const bf16*)(wl + W_OUT), MTOK, DM, DM}; pg8::HybridOrder S; S.init(DM, gridDim.x, blockIdx.x);
                    pg8::EpiPlain E{U, DM, one, (WS_D1 - WS_U) / 2};
                    pg8::gemm_phase<pg8::EpiPlain, pg8::HybridOrder, true, true>(lds, g, S, E);
                }
                SEAM(pb + 5);
                if (IN(pb + 6)) {
                    FRESH();
                    norm_phase<8, true, false>(Hb, Hb + (size_t)MP * DM, U, Hb, D1b, ng + 3 * DM, 1.0f, ng + 4 * DM, gw, ngw, lane);
                }
                SEAM(pb + 6);
            }
        }
    }
#undef IN
#undef SEAM
#undef FRESH
}

extern "C" void kernel_launch(void* const* d_in, const int* in_sizes, int n_in, void* d_out, int out_size, void* d_ws, size_t ws_size, hipStream_t stream) {
    static int grid = 0;
    if (grid == 0) {
        if (n_in != 23 || (size_t)out_size != O_END || ws_size < WS_END) { fprintf(stderr, "kernel_launch: unexpected shapes: n_in %d out %d ws %zu\n", n_in, out_size, ws_size); grid = -1; return; }
        int dev = 0, cus = 0, per_cu = 0;
        hipGetDevice(&dev); hipDeviceGetAttribute(&cus, hipDeviceAttributeMultiprocessorCount, dev);
        if (hipFuncSetAttribute((const void*)mega_fwd, hipFuncAttributeMaxDynamicSharedMemorySize, LDS_BYTES) != hipSuccess) { fprintf(stderr, "kernel_launch: hipFuncSetAttribute failed\n"); grid = -1; return; }
        if (hipOccupancyMaxActiveBlocksPerMultiprocessor(&per_cu, (const void*)mega_fwd, 512, LDS_BYTES) != hipSuccess || per_cu < 1) { fprintf(stderr, "kernel_launch: occupancy query says %d\n", per_cu); per_cu = 1; }
        (void)hipGetLastError();
        grid = cus * 1;
        if (grid != 256) { fprintf(stderr, "kernel_launch: built for a 256-CU device (hybrid split-K order); got %d\n", grid); grid = -1; return; }
        fprintf(stderr, "kernel_launch: grid %d (cus %d, per_cu %d)\n", grid, cus, per_cu);
    }
    if (grid < 0) return;
    if (hipMemsetAsync(d_ws, 0, 16384, stream) != hipSuccess) { fprintf(stderr, "kernel_launch: memset of the barrier words failed\n"); return; }
    Params a{};
    for (int i = 0; i < 23; ++i) a.in[i] = (const float*)d_in[i];
    a.out = (float*)d_out; a.ws = (unsigned char*)d_ws; a.one = 1.0f;
#if MK_MULTI_LAUNCH
    for (int k = 0; k < NPH; ++k) { a.ph_lo = k; a.ph_hi = k + 1; hipLaunchKernelGGL(mega_fwd, dim3(grid), dim3(512), LDS_BYTES, stream, a); }
#else
    a.ph_lo = 0; a.ph_hi = NPH;
    void* args[] = {&a};
    hipError_t e = hipLaunchCooperativeKernel((const void*)mega_fwd, dim3(grid), dim3(512), args, LDS_BYTES, stream);
    if (e != hipSuccess) fprintf(stderr, "kernel_launch: cooperative launch failed: %s (grid %d)\n", hipGetErrorString(e), grid);
#endif
}
```
